# Optimizing an MI355X kernel written in HIP

```python
import jax, jax.numpy as jnp
from jax import lax
import numpy as np

D_MODEL = 2048
BATCH = 4
SEQ = 2048
DEPTH = 1
DEC_BATCH = 32
DEC_SEQ = 32
PAST_LEN = 1024

CHUNK = 64
MIX_WIDTH = D_MODEL
ATTN_WIDTH = MIX_WIDTH // 2
GMLP_WIDTH = MIX_WIDTH - ATTN_WIDTH
N_HEADS = 8
NOPE_DIM = 128
ROPE_DIM = 64
QK_DIM = NOPE_DIM + ROPE_DIM
V_DIM = ATTN_WIDTH // N_HEADS
Q_RANK = 512
KV_RANK = 256
GMLP_GROUPS = 8
GMLP_GROUP_DIM = GMLP_WIDTH // GMLP_GROUPS
GMLP_CHUNK = 128
D_FF = 4 * D_MODEL
IN_WIDTH = Q_RANK + KV_RANK + ROPE_DIM + 2 * GMLP_WIDTH
ROPE_THETA = 10000.0
EPS = 1e-6
Q_BLOCK = 128

kernel_name = "hymba_mla_gmlp_stream_step"


def rmsnorm(x, g):
    xf = x.astype(jnp.float32)
    y = xf * lax.rsqrt(jnp.mean(jnp.square(xf), axis=-1, keepdims=True) + EPS)
    return (y * g.astype(jnp.float32)).astype(x.dtype)


def rope(x, pos):
    half = ROPE_DIM // 2
    inv = ROPE_THETA ** (-jnp.arange(half, dtype=jnp.float32) / half)
    ang = pos.astype(jnp.float32)[:, None] * inv[None, :]
    ang = ang.reshape(ang.shape[:1] + (1,) * (x.ndim - 3) + (half,))
    cos, sin = jnp.cos(ang), jnp.sin(ang)
    xf = x.astype(jnp.float32)
    x1, x2 = xf[..., :half], xf[..., half:]
    return jnp.concatenate([x1 * cos - x2 * sin, x1 * sin + x2 * cos], axis=-1).astype(x.dtype)


def qk_gain(g_nope, g_rope):
    return jnp.concatenate([g_nope, g_rope, g_rope], axis=-1)


def project(x, pos, p):
    b, t, _ = x.shape
    z = rmsnorm(x, p["norm_mix"]) @ p["w_in"]
    s1 = Q_RANK
    s2 = s1 + KV_RANK
    s3 = s2 + ROPE_DIM
    s4 = s3 + GMLP_WIDTH
    q_lat, kv_lat, k_pe, u, v = jnp.split(z, [s1, s2, s3, s4], axis=-1)
    q = (rmsnorm(q_lat, p["q_lat_norm"]) @ p["w_uq"]).reshape(b, t, N_HEADS, QK_DIM)
    q = jnp.concatenate([q[..., :NOPE_DIM], rope(q[..., NOPE_DIM:], pos)], axis=-1)
    q = rmsnorm(q, qk_gain(p["q_norm_nope"], p["q_norm_rope"]))
    c_kv = rmsnorm(kv_lat, p["kv_lat_norm"])
    k_pe = rope(k_pe, pos)
    u = jax.nn.gelu(u).reshape(b, t, GMLP_GROUPS, GMLP_GROUP_DIM)
    v = rmsnorm(jax.nn.gelu(v).reshape(b, t, GMLP_GROUPS, GMLP_GROUP_DIM), p["v_norm"])
    return q, c_kv, k_pe, u, v


def expand_kv(c_kv, k_pe, p):
    b, l, _ = c_kv.shape
    k_nope = (c_kv @ p["w_uk"]).reshape(b, l, N_HEADS, NOPE_DIM)
    k_rot = jnp.broadcast_to(k_pe[:, :, None, :], (b, l, N_HEADS, ROPE_DIM))
    k = rmsnorm(jnp.concatenate([k_nope, k_rot], axis=-1), qk_gain(p["k_norm_nope"], p["k_norm_rope"]))
    v = (c_kv @ p["w_uv"]).reshape(b, l, N_HEADS, V_DIM)
    return k, v


def attend(q, k, v, q_pos, k_pos):
    s = jnp.einsum("bqhd,bkhd->bhqk", q, k).astype(jnp.float32) * (QK_DIM ** -0.5)
    mask = (k_pos[None, :] // CHUNK) <= (q_pos[:, None] // CHUNK)
    s = jnp.where(mask[None, None], s, jnp.finfo(jnp.float32).min)
    w = jax.nn.softmax(s, axis=-1).astype(v.dtype)
    return jnp.einsum("bhqk,bkhd->bqhd", w, v)


def spatial_gate(u, v, w_s, b_s):
    l = v.shape[2]
    w = jnp.tril(w_s[:, :l, :l])
    s = jnp.einsum("gts,bnsgc->bntgc", w, v) + b_s[:, :l].T[None, None, :, :, None]
    return u * s


def finish(x, attn_o, gmlp_o, p):
    m = jnp.concatenate([rmsnorm(attn_o, p["out_norm_attn"]), rmsnorm(gmlp_o, p["out_norm_gmlp"])], axis=-1)
    h = x + m @ p["w_out"]
    f = jnp.square(jax.nn.relu(rmsnorm(h, p["norm_ffn"]) @ p["w_up"])) @ p["w_down"]
    return h + f


def layer_prompt(x, p):
    b, t, _ = x.shape
    pos = jnp.arange(t, dtype=jnp.int32)
    q, c_kv, k_pe, u, v = project(x, pos, p)
    k, vv = expand_kv(c_kv, k_pe, p)
    nb = t // Q_BLOCK
    qb = q.reshape(b, nb, Q_BLOCK, N_HEADS, QK_DIM).transpose(1, 0, 2, 3, 4)
    pb = pos.reshape(nb, Q_BLOCK)
    o = lax.map(lambda a: attend(a[0], k, vv, a[1], pos), (qb, pb))
    attn_o = o.transpose(1, 0, 2, 3, 4).reshape(b, t, ATTN_WIDTH)
    nc = t // GMLP_CHUNK
    shp = (b, nc, GMLP_CHUNK, GMLP_GROUPS, GMLP_GROUP_DIM)
    gmlp_o = spatial_gate(u.reshape(shp), v.reshape(shp), p["w_spatial"], p["b_spatial"]).reshape(b, t, GMLP_WIDTH)
    return finish(x, attn_o, gmlp_o, p), c_kv, k_pe


def layer_sample(x, cache_c_kv, cache_k_rope, p):
    b, t, _ = x.shape
    past = cache_c_kv.shape[1]
    q_pos = past + jnp.arange(t, dtype=jnp.int32)
    k_pos = jnp.arange(past + t, dtype=jnp.int32)
    q, c_kv, k_pe, u, v = project(x, q_pos, p)
    all_c = jnp.concatenate([cache_c_kv.astype(c_kv.dtype), c_kv], axis=1)
    all_pe = jnp.concatenate([cache_k_rope.astype(k_pe.dtype), k_pe], axis=1)
    k, vv = expand_kv(all_c, all_pe, p)
    attn_o = attend(q, k, vv, q_pos, k_pos).reshape(b, t, ATTN_WIDTH)
    gmlp_o = spatial_gate(u[:, None], v[:, None], p["w_spatial"], p["b_spatial"]).reshape(b, t, GMLP_WIDTH)
    return finish(x, attn_o, gmlp_o, p), c_kv, k_pe, v.reshape(b, t, GMLP_WIDTH)


def setup_inputs(seed: int = 0) -> dict:
    key = jax.random.key(seed)
    ks = list(jax.random.split(key, 32))
    f32 = jnp.float32

    def w(k, shape, fan_in):
        return jax.random.normal(k, (DEPTH,) + shape, f32) * (fan_in ** -0.5)

    def gain(k, shape):
        return 1.0 + 0.05 * jax.random.normal(k, (DEPTH,) + shape, f32)

    return {
        "x_prompt": jax.random.normal(ks[0], (BATCH, SEQ, D_MODEL), f32),
        "x_sample": jax.random.normal(ks[1], (DEC_BATCH, DEC_SEQ, D_MODEL), f32),
        "cache_c_kv": jax.random.normal(ks[2], (DEPTH, DEC_BATCH, PAST_LEN, KV_RANK), f32),
        "cache_k_rope": jax.random.normal(ks[3], (DEPTH, DEC_BATCH, PAST_LEN, ROPE_DIM), f32),
        "norm_mix": gain(ks[4], (D_MODEL,)),
        "w_in": w(ks[5], (D_MODEL, IN_WIDTH), D_MODEL),
        "q_lat_norm": gain(ks[6], (Q_RANK,)),
        "kv_lat_norm": gain(ks[7], (KV_RANK,)),
        "w_uq": w(ks[8], (Q_RANK, N_HEADS * QK_DIM), Q_RANK),
        "w_uk": w(ks[9], (KV_RANK, N_HEADS * NOPE_DIM), KV_RANK),
        "w_uv": w(ks[10], (KV_RANK, N_HEADS * V_DIM), KV_RANK),
        "q_norm_nope": gain(ks[11], (NOPE_DIM,)),
        "q_norm_rope": gain(ks[12], (ROPE_DIM // 2,)),
        "k_norm_nope": gain(ks[13], (NOPE_DIM,)),
        "k_norm_rope": gain(ks[14], (ROPE_DIM // 2,)),
        "v_norm": gain(ks[15], (GMLP_GROUPS, GMLP_GROUP_DIM)),
        "w_spatial": w(ks[16], (GMLP_GROUPS, GMLP_CHUNK, GMLP_CHUNK), GMLP_CHUNK),
        "b_spatial": gain(ks[17], (GMLP_GROUPS, GMLP_CHUNK)),
        "out_norm_attn": gain(ks[18], (ATTN_WIDTH,)),
        "out_norm_gmlp": gain(ks[19], (GMLP_WIDTH,)),
        "w_out": w(ks[20], (MIX_WIDTH, D_MODEL), MIX_WIDTH),
        "norm_ffn": gain(ks[21], (D_MODEL,)),
        "w_up": w(ks[22], (D_MODEL, D_FF), D_MODEL),
        "w_down": w(ks[23], (D_FF, D_MODEL), D_FF),
    }


def reference(x_prompt, x_sample, cache_c_kv, cache_k_rope, norm_mix, w_in, q_lat_norm, kv_lat_norm,
              w_uq, w_uk, w_uv, q_norm_nope, q_norm_rope, k_norm_nope, k_norm_rope, v_norm,
              w_spatial, b_spatial, out_norm_attn, out_norm_gmlp, w_out, norm_ffn, w_up, w_down):
    xp, xs = x_prompt, x_sample
    ckv_p, kpe_p, ckv_s, kpe_s, v_s = [], [], [], [], []
    for i in range(DEPTH):
        p = {
            "norm_mix": norm_mix[i], "w_in": w_in[i], "q_lat_norm": q_lat_norm[i],
            "kv_lat_norm": kv_lat_norm[i], "w_uq": w_uq[i], "w_uk": w_uk[i], "w_uv": w_uv[i],
            "q_norm_nope": q_norm_nope[i], "q_norm_rope": q_norm_rope[i],
            "k_norm_nope": k_norm_nope[i], "k_norm_rope": k_norm_rope[i], "v_norm": v_norm[i],
            "w_spatial": w_spatial[i], "b_spatial": b_spatial[i],
            "out_norm_attn": out_norm_attn[i], "out_norm_gmlp": out_norm_gmlp[i],
            "w_out": w_out[i], "norm_ffn": norm_ffn[i], "w_up": w_up[i], "w_down": w_down[i],
        }
        xp, c_p, k_p = layer_prompt(xp, p)
        xs, c_s, k_s, vrow = layer_sample(xs, cache_c_kv[i], cache_k_rope[i], p)
        ckv_p.append(c_p)
        kpe_p.append(k_p)
        ckv_s.append(c_s)
        kpe_s.append(k_s)
        v_s.append(vrow)
    new_c_kv_prompt = jnp.stack(ckv_p)
    new_k_rope_prompt = jnp.stack(kpe_p)
    new_c_kv_sample = jnp.stack(ckv_s)
    new_k_rope_sample = jnp.stack(kpe_s)
    new_gmlp_v_sample = jnp.stack(v_s)
    return (xp, xs, new_c_kv_prompt, new_k_rope_prompt, new_c_kv_sample, new_k_rope_sample, new_gmlp_v_sample)
```

```cpp
#include <hip/hip_runtime.h>
#include <hip/hip_cooperative_groups.h>
#include <cstdio>
namespace cg = cooperative_groups;

#ifndef MK_SINGLE_LAUNCH
#define MK_SINGLE_LAUNCH 1
#endif

#define DI __device__ __forceinline__
typedef unsigned short bf16_t;
typedef short bf16x8 __attribute__((ext_vector_type(8)));
typedef short s16x4 __attribute__((ext_vector_type(4)));
typedef float f32x4 __attribute__((ext_vector_type(4)));
typedef float f32x16 __attribute__((ext_vector_type(16)));
typedef __bf16 bfv2 __attribute__((ext_vector_type(2)));
typedef float fv2 __attribute__((ext_vector_type(2)));
typedef unsigned u32x4 __attribute__((ext_vector_type(4)));
#define VTID ((int)(threadIdx.x & 255))
#define VHALF ((int)(threadIdx.x >> 8))
#define VB ((int)(blockIdx.x * 2 + (threadIdx.x >> 8)))
#define NVB ((int)(gridDim.x * 2))

constexpr int NTOK = 9216;
constexpr int NPT = 8192;
constexpr int NKEY = 41984;
constexpr int NKEYP = 42048;
constexpr int ZLD = 3072;
constexpr float EPS = 1e-6f;

constexpr size_t O_YS = 16777216, O_CKVP = 18874368, O_KPEP = 20971520, O_CKVS = 21495808, O_KPES = 21757952, O_VS = 21823488;
constexpr size_t DO_U = 0, DO_V = 18874368, DO_ALLC = 37748736, DO_ALLPE = 59244544;
constexpr size_t WS_WUQ = 0;
constexpr size_t WS_WUK = WS_WUQ + 1572864;
constexpr size_t WS_WUV = WS_WUK + 524288;
constexpr size_t WS_WOUT = WS_WUV + 524288;
constexpr size_t WS_WSPP = WS_WOUT + 8388608;
constexpr size_t WS_WSPS = WS_WSPP + 262144;
constexpr size_t WS_ROPE = WS_WSPS + 262144;
constexpr size_t WS_RSK = WS_ROPE + 524288;
constexpr size_t WS_CNT = WS_RSK + 1345536;
constexpr size_t WS_BAR = WS_CNT + 256;
constexpr size_t WS_HSS = WS_BAR + 16384;
constexpr size_t WS_A = WS_HSS + 36864;
constexpr size_t WS_QN = WS_A + 28311552;
constexpr size_t WS_BIG = WS_A + 37748736;
constexpr size_t WS_WIN = WS_BIG;
constexpr size_t WS_Z = WS_BIG + 12582912;
constexpr size_t WS_KN = WS_BIG;
constexpr size_t WS_VT = WS_BIG + 86114304;
constexpr size_t WS_ACT = WS_BIG;
constexpr size_t WS_WUP = WS_BIG + 172228608;
constexpr size_t WS_WDN = WS_WUP + 33554432;
constexpr size_t WS_TOTAL = WS_WDN + 33554432;

struct Params {
  const float *xp, *xs, *cache_c, *cache_pe, *norm_mix, *w_in, *q_lat_norm, *kv_lat_norm, *w_uq, *w_uk, *w_uv;
  const float *q_norm_nope, *q_norm_rope, *k_norm_nope, *k_norm_rope, *v_norm, *w_spatial, *b_spatial;
  const float *out_norm_attn, *out_norm_gmlp, *w_out, *norm_ffn, *w_up, *w_down;
  float* out;
  char* ws;
  int phase_lo, phase_hi, coop, pad;
};

DI unsigned pack2(float a, float b) { fv2 v = {a, b}; bfv2 r = __builtin_convertvector(v, bfv2); return __builtin_bit_cast(unsigned, r); }
DI float bflo(unsigned u) { return __uint_as_float(u << 16); }
DI float bfhi(unsigned u) { return __uint_as_float(u & 0xffff0000u); }
DI float wave_sum(float v) {
#pragma unroll
  for (int o = 32; o > 0; o >>= 1) v += __shfl_xor(v, o);
  return v;
}
DI float grp_sum(float v, int width) {
#pragma unroll
  for (int o = 1; o < 16; o <<= 1) if (o < width) v += __shfl_xor(v, o);
  return v;
}
DI float gelu_tanh(float x) {
  const float y = 0.7978845608028654f * (x + 0.044715f * x * x * x);
  const float e = __builtin_amdgcn_exp2f(y * 2.8853900817779268f);
  return x - x * __builtin_amdgcn_rcpf(1.0f + e);
}
DI void unpack8(uint4 d, float* f) {
  f[0] = bflo(d.x); f[1] = bfhi(d.x); f[2] = bflo(d.y); f[3] = bfhi(d.y);
  f[4] = bflo(d.z); f[5] = bfhi(d.z); f[6] = bflo(d.w); f[7] = bfhi(d.w);
}
DI uint4 pack8(const float* f) { return make_uint4(pack2(f[0], f[1]), pack2(f[2], f[3]), pack2(f[4], f[5]), pack2(f[6], f[7])); }


#define XB_TMO      128
#define XB_XCNT(j)  (256  + 64 * (j))
#define XB_XSUB(j)  (1280 + 64 * (j))
#define XB_XGEN(j)  (2304 + 64 * (j))
#define XB_TOP      3328
#define XB_TOPGEN   3392
#define XCD_BAR_WORDS 3456
#define XB_SPIN_CAP (1u << 18)
#define LAS __attribute__((address_space(3)))
DI unsigned xb_ld(unsigned* p) { return __hip_atomic_load(p, __ATOMIC_RELAXED, __HIP_MEMORY_SCOPE_AGENT); }
DI unsigned xb_add(unsigned* p, unsigned v) { return __hip_atomic_fetch_add(p, v, __ATOMIC_RELAXED, __HIP_MEMORY_SCOPE_AGENT); }
DI unsigned xb_xcc_id() { return (unsigned)__builtin_amdgcn_s_getreg((3 << 11) | 20) & 0xFu; }
#define XB_SPIN(cond, bar) do { unsigned _sp = 0; while (cond) { __builtin_amdgcn_s_sleep(1); \
    if ((++_sp & 255u) == 0u) { if (xb_ld(&(bar)[XB_TMO])) break; if (_sp > XB_SPIN_CAP) { atomicAdd(&(bar)[XB_TMO], 1u); break; } } } } while (0)
struct XcdBarrier { unsigned* bar; unsigned x; volatile LAS unsigned* st; };
DI XcdBarrier xcd_barrier_post(unsigned* bar, volatile LAS unsigned* st) {
  XcdBarrier b; b.bar = bar; b.x = xb_xcc_id(); b.st = st;
  if (threadIdx.x == 0) (void)xb_add(&bar[XB_XCNT(b.x)], 1u);
  return b;
}
DI void xcd_barrier_complete(unsigned* bar, unsigned x, unsigned& nloc, unsigned& nx) {
  const unsigned G = gridDim.x * gridDim.y * gridDim.z;
  unsigned sum, cnt, mine, sp = 0u;
  for (;;) {
    sum = 0u; cnt = 0u; mine = 0u;
#pragma unroll
    for (unsigned j = 0; j < 16; ++j) { const unsigned c = xb_ld(&bar[XB_XCNT(j)]); sum += c; cnt += (c > 0u) ? 1u : 0u; mine = (j == x) ? c : mine; }
    if (sum == G) break;
    __builtin_amdgcn_s_sleep(1);
    if ((++sp & 255u) == 0u) { if (xb_ld(&bar[XB_TMO])) break; if (sp > XB_SPIN_CAP) { atomicAdd(&bar[XB_TMO], 1u); break; } }
  }
  nloc = mine > 0u ? mine : 1u; nx = cnt > 0u ? cnt : 1u;
}
DI void xcd_barrier(const XcdBarrier& b) {
  asm volatile("s_waitcnt vmcnt(0)" ::: "memory");
  __syncthreads();
  if (threadIdx.x == 0) {
    unsigned* bar = b.bar;
    __builtin_amdgcn_s_waitcnt(0);
    unsigned nloc = b.st[0], nx = b.st[1];
    if (nloc == 0u) { xcd_barrier_complete(bar, b.x, nloc, nx); b.st[0] = nloc; b.st[1] = nx; }
    const unsigned old = xb_add(&bar[XB_XSUB(b.x)], 1u);
    const unsigned gen = old / nloc;
    if (old + 1u == (gen + 1u) * nloc) {
      __builtin_amdgcn_fence(__ATOMIC_RELEASE, "agent");
      asm volatile("s_waitcnt vmcnt(0)" ::: "memory");
      const unsigned og = xb_add(&bar[XB_TOP], 1u);
      const unsigned tg = og / nx;
      if (og + 1u == (tg + 1u) * nx) xb_add(&bar[XB_TOPGEN], 1u);
      else XB_SPIN(xb_ld(&bar[XB_TOPGEN]) == tg, bar);
      __builtin_amdgcn_fence(__ATOMIC_ACQUIRE, "agent");
      xb_add(&bar[XB_XGEN(b.x)], 1u);
      asm volatile("s_waitcnt vmcnt(0)" ::: "memory");
    } else {
      XB_SPIN(xb_ld(&bar[XB_XGEN(b.x)]) == gen, bar);
      __builtin_amdgcn_fence(__ATOMIC_ACQUIRE, "agent");
      asm volatile("s_waitcnt vmcnt(0)" ::: "memory");
    }
  }
  __syncthreads();
}

DI void glds16(const void* gsrc, unsigned lds_dst) {
  unsigned keep;
  asm volatile("s_mov_b32 %0, m0\n\ts_mov_b32 m0, %2\n\ts_nop 0\n\tglobal_load_lds_dwordx4 %1, off\n\ts_mov_b32 m0, %0"
               : "=&s"(keep) : "v"(gsrc), "s"(lds_dst) : "memory");
}

DI void glds16s(const void* sbase, unsigned voff, unsigned lds_dst) {
  unsigned keep;
  lds_dst = __builtin_amdgcn_readfirstlane(lds_dst);
  { const unsigned long long b_ = (unsigned long long)sbase;
    const unsigned lo_ = __builtin_amdgcn_readfirstlane((unsigned)b_), hi_ = __builtin_amdgcn_readfirstlane((unsigned)(b_ >> 32));
    sbase = (const void*)(((unsigned long long)hi_ << 32) | lo_); }
  asm volatile("s_mov_b32 %0, m0\n\ts_mov_b32 m0, %3\n\ts_nop 0\n\tglobal_load_lds_dwordx4 %1, %2\n\ts_mov_b32 m0, %0"
               : "=&s"(keep) : "v"(voff), "s"(sbase), "s"(lds_dst) : "memory");
}

DI int lds_byte(int r, int c) {
  const int st = (r >> 4) * 2 + (c >> 5), rr = r & 15, cc = c & 31, ob = rr * 64 + cc * 2;
  return st * 1024 + (ob ^ (((ob >> 9) & 1) << 5));
}

DI int slot_index(int it) {
  const int nvb = NVB, nbr = gridDim.x, b = blockIdx.x;
  if ((nbr & 7) == 0) return it * nvb + (b & 7) * (nvb >> 3) + (b >> 3) * 2 + VHALF;
  return it * nvb + VB;
}

DI void transpose_tile(const float* __restrict__ src, int ldsrc, bf16_t* __restrict__ dst, int lddst, int k0, int n0, float* lds) {
  const int tid = VTID, kr = tid >> 4, nc = tid & 15;
#pragma unroll
  for (int i = 0; i < 4; ++i) {
    const float4 v = *(const float4*)(src + (size_t)(k0 + kr + 16 * i) * ldsrc + n0 + 4 * nc);
    float* d = lds + (kr + 16 * i) * 65 + 4 * nc;
    d[0] = v.x; d[1] = v.y; d[2] = v.z; d[3] = v.w;
  }
  __syncthreads();
  const int n = tid >> 2, kc = tid & 3;
  unsigned pk[8];
#pragma unroll
  for (int j = 0; j < 8; ++j) pk[j] = pack2(lds[(kc * 16 + 2 * j) * 65 + n], lds[(kc * 16 + 2 * j + 1) * 65 + n]);
  uint4* o = (uint4*)(dst + (size_t)(n0 + n) * lddst + k0 + kc * 16);
  o[0] = make_uint4(pk[0], pk[1], pk[2], pk[3]);
  o[1] = make_uint4(pk[4], pk[5], pk[6], pk[7]);
  __syncthreads();
}

DI void transpose_tile_blk(const float* __restrict__ src, int ldsrc, bf16_t* __restrict__ dst, int nk, int k0, int n0, float* lds) {
  const int tid = VTID, kr = tid >> 4, nc = tid & 15;
#pragma unroll
  for (int i = 0; i < 4; ++i) {
    const float4 v = *(const float4*)(src + (size_t)(k0 + kr + 16 * i) * ldsrc + n0 + 4 * nc);
    float* d = lds + (kr + 16 * i) * 65 + 4 * nc;
    d[0] = v.x; d[1] = v.y; d[2] = v.z; d[3] = v.w;
  }
  __syncthreads();
  const int n = tid >> 2, kc = tid & 3;
  unsigned pk[8];
#pragma unroll
  for (int j = 0; j < 8; ++j) pk[j] = pack2(lds[(kc * 16 + 2 * j) * 65 + n], lds[(kc * 16 + 2 * j + 1) * 65 + n]);
  const int nn = n0 + n, kk = k0 + kc * 16;
  uint4* o = (uint4*)(dst + ((size_t)((nn >> 8) * nk + (kk >> 5)) * 256 + (nn & 255)) * 32 + (kk & 31));
  o[0] = make_uint4(pk[0], pk[1], pk[2], pk[3]);
  o[1] = make_uint4(pk[4], pk[5], pk[6], pk[7]);
  __syncthreads();
}

DI void rms_row2048_blk(const float* __restrict__ src, const float* __restrict__ gain, bf16_t* __restrict__ base, int r, int lane) {
  float4 v[8];
  float ss = 0.f;
#pragma unroll
  for (int i = 0; i < 8; ++i) { v[i] = *(const float4*)(src + i * 256 + lane * 4); ss += v[i].x * v[i].x + v[i].y * v[i].y + v[i].z * v[i].z + v[i].w * v[i].w; }
  ss = wave_sum(ss);
  const float rs = rsqrtf(ss * (1.0f / 2048.0f) + EPS);
  const int tmr = r / 288, rr = r - tmr * 288;
#pragma unroll
  for (int i = 0; i < 8; ++i) {
    const float4 g = *(const float4*)(gain + i * 256 + lane * 4);
    uint2 o; o.x = pack2(v[i].x * rs * g.x, v[i].y * rs * g.y); o.y = pack2(v[i].z * rs * g.z, v[i].w * rs * g.w);
    const int c = i * 256 + lane * 4;
    *(uint2*)(base + ((size_t)(tmr * 64 + (c >> 5)) * 288 + rr) * 32 + (c & 31)) = o;
  }
}

DI void rms_row2048(const float* __restrict__ src, const float* __restrict__ gain, bf16_t* __restrict__ dst, int lane) {
  float4 v[8];
  float ss = 0.f;
#pragma unroll
  for (int i = 0; i < 8; ++i) { v[i] = *(const float4*)(src + i * 256 + lane * 4); ss += v[i].x * v[i].x + v[i].y * v[i].y + v[i].z * v[i].z + v[i].w * v[i].w; }
  ss = wave_sum(ss);
  const float rs = rsqrtf(ss * (1.0f / 2048.0f) + EPS);
#pragma unroll
  for (int i = 0; i < 8; ++i) {
    const float4 g = *(const float4*)(gain + i * 256 + lane * 4);
    uint2 o; o.x = pack2(v[i].x * rs * g.x, v[i].y * rs * g.y); o.y = pack2(v[i].z * rs * g.z, v[i].w * rs * g.w);
    *(uint2*)(dst + i * 256 + lane * 4) = o;
  }
}

DI void phase_prep(const Params& p, char* smem, const int part, const int b, const int nb) {
  const int tid = VTID, lane = tid & 63, wid = tid >> 6;
  char* ws = p.ws;
  {
    const int n_in = 32 * 45, n_uq = 8 * 24, n_uk = 4 * 16, n_uv = 4 * 16, n_out = 0;
    const int total = n_in + n_uq + n_uk + n_uv + n_out;
    for (int j = (part == 0 ? b : n_in + b); j < (part == 0 ? n_in : total); j += nb) {
      int t = j;
      if (t < n_in) { transpose_tile_blk(p.w_in, 2880, (bf16_t*)(ws + WS_WIN), 64, (t / 45) * 64, (t % 45) * 64, (float*)smem); continue; }
      t -= n_in;
      if (t < n_uq) { transpose_tile(p.w_uq, 1536, (bf16_t*)(ws + WS_WUQ), 512, (t / 24) * 64, (t % 24) * 64, (float*)smem); continue; }
      t -= n_uq;
      if (t < n_uk) { transpose_tile(p.w_uk, 1024, (bf16_t*)(ws + WS_WUK), 256, (t / 16) * 64, (t % 16) * 64, (float*)smem); continue; }
      t -= n_uk;
      if (t < n_uv) { transpose_tile(p.w_uv, 1024, (bf16_t*)(ws + WS_WUV), 256, (t / 16) * 64, (t % 16) * 64, (float*)smem); continue; }
      t -= n_uv;
      transpose_tile(p.w_out, 2048, (bf16_t*)(ws + WS_WOUT), 2048, (t / 32) * 64, (t % 32) * 64, (float*)smem);
    }
  }
  const int gtid = b * 256 + tid, gthreads = nb * 256;
  if (part == 0) {
  for (int i = gtid; i < 64 * 768; i += gthreads) {
    const int ks = i / 768, off = i - ks * 768;
    ((uint4*)(ws + WS_WIN + ((size_t)((11 * 64 + ks) * 256 + 64) * 32) * 2))[off] = make_uint4(0, 0, 0, 0);
  }
  for (int i = gtid; i < NKEYP * 8 / 4; i += gthreads) ((float4*)(ws + WS_RSK))[i] = make_float4(0.f, 0.f, 0.f, 0.f);
  for (int i = gtid; i < 8 * 128 * 128; i += gthreads) {
    const int g = i >> 14, t = (i >> 7) & 127, s = i & 127;
    const float wp = (s <= t) ? p.w_spatial[i] : 0.f;
    const float wsv = ((t >> 5) == (s >> 5) && (s & 31) <= (t & 31)) ? p.w_spatial[(g << 14) + ((t & 31) << 7) + (s & 31)] : 0.f;
    ((bf16_t*)(ws + WS_WSPP))[i] = (bf16_t)(pack2(wp, 0.f) & 0xffffu);
    ((bf16_t*)(ws + WS_WSPS))[i] = (bf16_t)(pack2(wsv, 0.f) & 0xffffu);
  }
  for (int i = gtid; i < 2048 * 32; i += gthreads) {
    const int pos = i >> 5, k = i & 31;
    const float inv = (float)exp2(-(double)k * (13.287712379549449 / 32.0));
    const float ang = (float)pos * inv;
    const double rev = (double)ang * 0.15915494309189535;
    const float fr = (float)(rev - rint(rev));
    float2 cs; cs.x = __builtin_amdgcn_cosf(fr); cs.y = __builtin_amdgcn_sinf(fr);
    ((float2*)(ws + WS_ROPE))[i] = cs;
  }
  }
  if (part == 1) {
    bf16_t* allc = (bf16_t*)((char*)p.out + DO_ALLC);
    for (int i = gtid; i < 32 * 1024 * 256 / 8; i += gthreads) {
      const int e = i * 8, c = e & 255, row = e >> 8, bb = row >> 10, pp = row & 1023;
      const float4 a = *(const float4*)(p.cache_c + e), d = *(const float4*)(p.cache_c + e + 4);
      *(uint4*)(allc + (size_t)(NPT + bb * 1056 + pp) * 256 + c) = make_uint4(pack2(a.x, a.y), pack2(a.z, a.w), pack2(d.x, d.y), pack2(d.z, d.w));
    }
    bf16_t* allpe = (bf16_t*)((char*)p.out + DO_ALLPE);
    for (int i = gtid; i < 32 * 1024 * 64 / 8; i += gthreads) {
      const int e = i * 8, c = e & 63, row = e >> 6, bb = row >> 10, pp = row & 1023;
      const float4 a = *(const float4*)(p.cache_pe + e), d = *(const float4*)(p.cache_pe + e + 4);
      *(uint4*)(allpe + (size_t)(NPT + bb * 1056 + pp) * 64 + c) = make_uint4(pack2(a.x, a.y), pack2(a.z, a.w), pack2(d.x, d.y), pack2(d.z, d.w));
    }
  }
  if (part == 0) {
    bf16_t* xn = (bf16_t*)(ws + WS_A);
    for (int r = b * 4 + wid; r < NTOK; r += nb * 4) {
      const float* src = r < NPT ? p.xp + (size_t)r * 2048 : p.xs + (size_t)(r - NPT) * 2048;
      rms_row2048_blk(src, p.norm_mix, xn, r, lane);
    }
  }
}

struct GemmArgs {
  const bf16_t* A; int lda;
  const bf16_t* B; int ldb;
  int TM, TN, K;
  int mode;
  bf16_t* ob; int ldo;
  int blk;
  int oblk;
  const float* gain;
  float* rss;
};

DI void mma_kstep(const char* sa, const char* sb, f32x4 (&acc)[4][4], int wr, int wc, int fr, int fq) {
#pragma unroll
  for (int k = 0; k < 2; ++k) {
    bf16x8 a[4], bq[4];
#pragma unroll
    for (int m = 0; m < 4; ++m) a[m] = *(const bf16x8*)(sa + lds_byte(wr * 64 + m * 16 + fr, k * 32 + fq * 8));
#pragma unroll
    for (int n = 0; n < 4; ++n) bq[n] = *(const bf16x8*)(sb + lds_byte(wc * 64 + n * 16 + fr, k * 32 + fq * 8));
#pragma unroll
    for (int m = 0; m < 4; ++m)
#pragma unroll
      for (int n = 0; n < 4; ++n) acc[m][n] = __builtin_amdgcn_mfma_f32_16x16x32_bf16(bq[n], a[m], acc[m][n], 0, 0, 0);
  }
}

DI void gemm_tile(const Params& p, const GemmArgs& g, int tm, int tn, char* smem, int kt0 = 0, int kt1 = -1) {
  const int tid = VTID, lane = tid & 63, wid = tid >> 6, wr = wid >> 1, wc = wid & 1, fr = lane & 15, fq = lane >> 4;
  int sR, sC;
  {
    const int bb = tid * 16, st = bb >> 10, sb = bb & 1023, swz = sb ^ (((sb >> 9) & 1) << 5);
    sR = (st >> 1) * 16 + (swz >> 6); sC = (st & 1) * 32 + ((swz & 63) >> 1);
  }
  const bf16_t* Ag = g.A + (size_t)(tm * 128 + sR) * g.lda + sC;
  const bf16_t* Bg = g.B + (size_t)(tn * 128 + sR) * g.ldb + sC;
  const size_t astep = (size_t)32 * g.lda, bstep = (size_t)32 * g.ldb;
  f32x4 acc[4][4];
#pragma unroll
  for (int m = 0; m < 4; ++m)
#pragma unroll
    for (int n = 0; n < 4; ++n) acc[m][n] = (f32x4){0.f, 0.f, 0.f, 0.f};
  const int nk = kt1 < 0 ? (g.K >> 6) : kt1;
  const bool partial = (kt0 != 0) || (nk != (g.K >> 6));
  const unsigned lds_wave = __builtin_amdgcn_readfirstlane((unsigned)(size_t)smem + wid * 1024);
#define GEMM_STAGE(kt, buf) do { \
    const unsigned d_ = lds_wave + (buf) * 32768; \
    const bf16_t* a_ = Ag + (kt) * 64; const bf16_t* b_ = Bg + (kt) * 64; \
    _Pragma("unroll") for (int i_ = 0; i_ < 4; ++i_) { \
      glds16(a_ + i_ * astep, d_ + i_ * 4096); \
      glds16(b_ + i_ * bstep, d_ + 16384 + i_ * 4096); } } while (0)
  GEMM_STAGE(kt0, kt0 & 1);
  for (int kt = kt0; kt < nk; ++kt) {
    const int buf = kt & 1;
    asm volatile("s_waitcnt vmcnt(0)" ::: "memory");
    __syncthreads();
    if (kt + 1 < nk) GEMM_STAGE(kt + 1, buf ^ 1);
    const char* sa = smem + buf * 32768; const char* sb = sa + 16384;
    bf16x8 af[2][4], bfr[2][4];
#pragma unroll
    for (int k = 0; k < 2; ++k) {
#pragma unroll
      for (int m = 0; m < 4; ++m) af[k][m] = *(const bf16x8*)(sa + lds_byte(wr * 64 + m * 16 + fr, k * 32 + fq * 8));
#pragma unroll
      for (int n = 0; n < 4; ++n) bfr[k][n] = *(const bf16x8*)(sb + lds_byte(wc * 64 + n * 16 + fr, k * 32 + fq * 8));
    }
#pragma unroll
    for (int k = 0; k < 2; ++k)
#pragma unroll
      for (int m = 0; m < 4; ++m)
#pragma unroll
        for (int n = 0; n < 4; ++n) acc[m][n] = __builtin_amdgcn_mfma_f32_16x16x32_bf16(bfr[k][n], af[k][m], acc[m][n], 0, 0, 0);
  }
  __syncthreads();
  const int row0 = tm * 128 + wr * 64 + fr, col0 = tn * 128 + wc * 64 + fq * 4;
  if (g.mode <= 1) {
    if (g.rss) {
#pragma unroll
      for (int m = 0; m < 4; ++m) {
        float ss = 0.f;
#pragma unroll
        for (int n = 0; n < 4; ++n)
#pragma unroll
          for (int j = 0; j < 4; ++j) ss += acc[m][n][j] * acc[m][n][j];
        ss += __shfl_xor(ss, 16); ss += __shfl_xor(ss, 32);
        if (fq == 0) unsafeAtomicAdd(g.rss + (size_t)(row0 + m * 16) * 8 + tn, ss);
      }
    }
    const int odd = fq & 1;
    const int cpair = odd ? 16 + (fq - 1) * 4 : fq * 4;
#pragma unroll
    for (int m = 0; m < 4; ++m) {
      const int row = row0 + m * 16;
      uint2 o[4];
#pragma unroll
      for (int n = 0; n < 4; ++n) {
        f32x4 v = acc[m][n];
        if (g.mode == 1) {
#pragma unroll
          for (int j = 0; j < 4; ++j) { const float r = fmaxf(v[j], 0.f); v[j] = r * r; }
        }
        o[n].x = pack2(v[0], v[1]); o[n].y = pack2(v[2], v[3]);
      }
      bf16_t* rowp = g.oblk == 2 ? g.ob + ((size_t)tn * NKEYP + row) * 128 + wc * 64 : g.ob + (size_t)row * g.ldo + tn * 128 + wc * 64;
#pragma unroll
      for (int j = 0; j < 2; ++j) {
        const uint2 keep = odd ? o[2 * j + 1] : o[2 * j];
        const uint2 send = odd ? o[2 * j] : o[2 * j + 1];
        uint2 recv; recv.x = __shfl_xor(send.x, 16); recv.y = __shfl_xor(send.y, 16);
        const uint4 wv = odd ? make_uint4(recv.x, recv.y, keep.x, keep.y) : make_uint4(keep.x, keep.y, recv.x, recv.y);
        *(uint4*)(rowp + j * 32 + cpair) = wv;
      }
    }
  } else if (g.mode == 2) {
#pragma unroll
    for (int m = 0; m < 4; ++m) {
      const int row = row0 + m * 16;
      const float* xr = (row < NPT ? p.xp + (size_t)row * 2048 : p.xs + (size_t)(row - NPT) * 2048) + col0;
      float* hr = p.out + (size_t)row * 2048 + col0;
#pragma unroll
      for (int n = 0; n < 4; ++n) {
        const float4 x = *(const float4*)(xr + n * 16);
        float4 o; o.x = x.x + acc[m][n][0]; o.y = x.y + acc[m][n][1]; o.z = x.z + acc[m][n][2]; o.w = x.w + acc[m][n][3];
        *(float4*)(hr + n * 16) = o;
      }
    }
  } else {
#pragma unroll
    for (int m = 0; m < 4; ++m) {
      float* hr = p.out + (size_t)(row0 + m * 16) * 2048 + col0;
#pragma unroll
      for (int n = 0; n < 4; ++n) {
        if (partial) {
          float* hp = hr + n * 16;
          unsafeAtomicAdd(hp, acc[m][n][0]); unsafeAtomicAdd(hp + 1, acc[m][n][1]); unsafeAtomicAdd(hp + 2, acc[m][n][2]); unsafeAtomicAdd(hp + 3, acc[m][n][3]);
        } else {
          float4 x = *(const float4*)(hr + n * 16);
          x.x += acc[m][n][0]; x.y += acc[m][n][1]; x.z += acc[m][n][2]; x.w += acc[m][n][3];
          *(float4*)(hr + n * 16) = x;
        }
      }
    }
  }
}


DI void gemm_tile_b(const Params& p, const GemmArgs& g, int tm, int tn, char* smem) {
  tm = __builtin_amdgcn_readfirstlane(tm); tn = __builtin_amdgcn_readfirstlane(tn);
  const int tid = VTID, lane = tid & 63, wid = tid >> 6, fr = lane & 15, fq = lane >> 4;
  int sR, sC;
  { const int sb = lane * 16, swz = sb ^ (((sb >> 9) & 1) << 5); sR = swz >> 6; sC = (swz & 63) >> 1; }
  const bf16_t* Ag = g.A + (size_t)(tm * 144) * g.lda;
  const bf16_t* Bg = g.B + (size_t)(tn * 256) * g.ldb;
  const unsigned voff = (unsigned)(sR * g.lda + sC) * 2u;
  const size_t a16 = (size_t)16 * g.lda, b16 = (size_t)16 * g.ldb;
  const int fo = (fr * 64 + fq * 16) ^ ((((fr * 64 + fq * 16) >> 9) & 1) << 5);
  const unsigned lds0 = __builtin_amdgcn_readfirstlane((unsigned)(size_t)smem);
  const int widu = __builtin_amdgcn_readfirstlane(wid);
  f32x4 acc[9][4];
#pragma unroll
  for (int m = 0; m < 9; ++m)
#pragma unroll
    for (int n = 0; n < 4; ++n) acc[m][n] = (f32x4){0.f, 0.f, 0.f, 0.f};
  const int nk = g.K >> 5;
#define GB_PIECE(kt, buf, i_) do { \
    int q_ = widu + 4 * (i_); if (q_ >= 25) q_ -= 4; \
    { \
      const unsigned d_ = lds0 + (buf) * 25600 + q_ * 1024; \
      if (q_ < 9) glds16s(Ag + (size_t)q_ * a16 + (kt) * 32, voff, d_); \
      else glds16s(Bg + (size_t)(q_ - 9) * b16 + (kt) * 32, voff, d_); } } while (0)
#pragma unroll
  for (int i = 0; i < 7; ++i) GB_PIECE(0, 0, i);
#pragma unroll
  for (int i = 0; i < 7; ++i) GB_PIECE(1, 1, i);
  int buf = 0, nbuf = 2;
  const int half = __builtin_amdgcn_readfirstlane(VHALF);
  if (half == 1) __builtin_amdgcn_s_barrier();
#pragma nounroll
  for (int kt = 0; kt < nk; ++kt) {
    if (kt + 1 < nk) asm volatile("s_waitcnt vmcnt(7)" ::: "memory");
    else asm volatile("s_waitcnt vmcnt(0)" ::: "memory");
    __builtin_amdgcn_s_barrier();
    if (kt + 2 < nk) {
#pragma unroll
      for (int i = 0; i < 7; ++i) GB_PIECE(kt + 2, nbuf, i);
    }
    const unsigned sa_addr = (unsigned)(size_t)smem + buf * 25600 + fo;
    const unsigned sb_addr = sa_addr + 9216 + wid * 4096;
    bf16x8 af[9], bfr[4];
    asm volatile(
        "ds_read_b128 %0, %14\n\t"
        "ds_read_b128 %1, %14 offset:1024\n\t"
        "ds_read_b128 %2, %14 offset:2048\n\t"
        "ds_read_b128 %3, %14 offset:3072\n\t"
        "ds_read_b128 %4, %13\n\t"
        "ds_read_b128 %5, %13 offset:1024\n\t"
        "ds_read_b128 %6, %13 offset:2048\n\t"
        "ds_read_b128 %7, %13 offset:3072\n\t"
        "ds_read_b128 %8, %13 offset:4096\n\t"
        "ds_read_b128 %9, %13 offset:5120\n\t"
        "ds_read_b128 %10, %13 offset:6144\n\t"
        "ds_read_b128 %11, %13 offset:7168\n\t"
        "ds_read_b128 %12, %13 offset:8192"
        : "=&v"(bfr[0]), "=&v"(bfr[1]), "=&v"(bfr[2]), "=&v"(bfr[3]), "=&v"(af[0]), "=&v"(af[1]), "=&v"(af[2]), "=&v"(af[3]), "=&v"(af[4]),
          "=&v"(af[5]), "=&v"(af[6]), "=&v"(af[7]), "=&v"(af[8])
        : "v"(sa_addr), "v"(sb_addr) : "memory");
    __builtin_amdgcn_s_barrier();
    __builtin_amdgcn_s_setprio(1);
#define GB_WAIT(n_, v_) asm volatile("s_waitcnt lgkmcnt(" #n_ ")" : "+v"(v_))
#define GB_ROW(m_) _Pragma("unroll") for (int n = 0; n < 4; ++n) acc[m_][n] = __builtin_amdgcn_mfma_f32_16x16x32_bf16(bfr[n], af[m_], acc[m_][n], 0, 0, 0)
    GB_WAIT(8, af[0]); GB_ROW(0);
    GB_WAIT(7, af[1]); GB_ROW(1);
    GB_WAIT(6, af[2]); GB_ROW(2);
    GB_WAIT(5, af[3]); GB_ROW(3);
    GB_WAIT(4, af[4]); GB_ROW(4);
    GB_WAIT(3, af[5]); GB_ROW(5);
    GB_WAIT(2, af[6]); GB_ROW(6);
    GB_WAIT(1, af[7]); GB_ROW(7);
    GB_WAIT(0, af[8]); GB_ROW(8);
    __builtin_amdgcn_s_setprio(0);
    buf = buf == 2 ? 0 : buf + 1;
    nbuf = nbuf == 2 ? 0 : nbuf + 1;
  }
  if (half == 0) __builtin_amdgcn_s_barrier();
  __syncthreads();
  const int row0 = tm * 144 + fr, col0 = tn * 256 + wid * 64 + fq * 4;
  if (g.mode == 1) {
#pragma unroll
    for (int m = 0; m < 9; ++m) {
      bf16_t* rp = g.ob + (size_t)(row0 + m * 16) * g.ldo + col0;
#pragma unroll
      for (int n = 0; n < 4; ++n) {
        f32x4 v = acc[m][n];
#pragma unroll
        for (int j = 0; j < 4; ++j) { const float r = fmaxf(v[j], 0.f); v[j] = r * r; }
        uint2 o; o.x = pack2(v[0], v[1]); o.y = pack2(v[2], v[3]);
        *(uint2*)(rp + n * 16) = o;
      }
    }
  } else if (g.mode == 2) {
#pragma unroll
    for (int m = 0; m < 9; ++m) {
      const int row = row0 + m * 16;
      const float* xr = (row < NPT ? p.xp + (size_t)row * 2048 : p.xs + (size_t)(row - NPT) * 2048) + col0;
      float* hr = p.out + (size_t)row * 2048 + col0;
#pragma unroll
      for (int n = 0; n < 4; ++n) {
        const float4 x = *(const float4*)(xr + n * 16);
        float4 o; o.x = x.x + acc[m][n][0]; o.y = x.y + acc[m][n][1]; o.z = x.z + acc[m][n][2]; o.w = x.w + acc[m][n][3];
        *(float4*)(hr + n * 16) = o;
      }
      asm volatile("" ::: "memory");
    }
  } else {
#pragma unroll
    for (int m = 0; m < 9; ++m) {
      float* hr = p.out + (size_t)(row0 + m * 16) * 2048 + col0;
#pragma unroll
      for (int n = 0; n < 4; ++n) {
        float4 x = *(const float4*)(hr + n * 16);
        x.x += acc[m][n][0]; x.y += acc[m][n][1]; x.z += acc[m][n][2]; x.w += acc[m][n][3];
        *(float4*)(hr + n * 16) = x;
      }
      asm volatile("" ::: "memory");
    }
  }
}


DI void gemm_tile_c(const Params& p, const GemmArgs& g, int tm, int tn, char* smem) {
  const int lane = threadIdx.x & 63, fr = lane & 15, fq = lane >> 4;
  const int w = __builtin_amdgcn_readfirstlane((int)(threadIdx.x >> 6)), half = w >> 2, wn = w & 3;
  int sR, sC;
  { const int sb = lane * 16, swz = sb ^ (((sb >> 9) & 1) << 5); sR = swz >> 6; sC = (swz & 63) >> 1; }
  const int nkk = g.K >> 5;
  const bf16_t* Ag = g.blk ? g.A + (size_t)tm * nkk * 9216 : g.A + (size_t)(tm * 288) * g.lda;
  const bf16_t* Bg = g.blk ? g.B + (size_t)tn * nkk * 8192 : g.B + (size_t)(tn * 256) * g.ldb;
  const unsigned voff = g.blk ? (unsigned)(sR * 32 + sC) * 2u : (unsigned)(sR * g.lda + sC) * 2u;
  const size_t a16 = g.blk ? (size_t)512 : (size_t)16 * g.lda, b16 = g.blk ? (size_t)512 : (size_t)16 * g.ldb;
  const size_t kA = g.blk ? (size_t)9216 : (size_t)32, kB = g.blk ? (size_t)8192 : (size_t)32;
  const int fo = (fr * 64 + fq * 16) ^ ((((fr * 64 + fq * 16) >> 9) & 1) << 5);
  const unsigned lds0 = __builtin_amdgcn_readfirstlane((unsigned)(size_t)smem);
  f32x4 acc[9][4];
#pragma unroll
  for (int m = 0; m < 9; ++m)
#pragma unroll
    for (int n = 0; n < 4; ++n) acc[m][n] = (f32x4){0.f, 0.f, 0.f, 0.f};
  const int nk = g.K >> 5;
#define GC_PIECE(kt, i_) do { const unsigned d_ = lds0 + ((kt) & 3) * 34816; \
    if ((i_) == 0) glds16s(Ag + (size_t)w * a16 + (size_t)(kt) * kA, voff, d_ + w * 1024); \
    else if ((i_) == 1) glds16s(Ag + (size_t)(w + 8) * a16 + (size_t)(kt) * kA, voff, d_ + (w + 8) * 1024); \
    else if ((i_) == 2) glds16s(Bg + (size_t)w * b16 + (size_t)(kt) * kB, voff, d_ + 18432 + w * 1024); \
    else if ((i_) == 3) glds16s(Bg + (size_t)(w + 8) * b16 + (size_t)(kt) * kB, voff, d_ + 18432 + (w + 8) * 1024); \
    else if (w < 2) glds16s(Ag + (size_t)(w + 16) * a16 + (size_t)(kt) * kA, voff, d_ + (w + 16) * 1024); } while (0)
#pragma unroll
  for (int st = 0; st < 3; ++st)
    if (st < nk) {
#pragma unroll
      for (int i = 0; i < 5; ++i) GC_PIECE(st, i);
    }
  if (w < 2) asm volatile("s_waitcnt vmcnt(10)" ::: "memory"); else asm volatile("s_waitcnt vmcnt(8)" ::: "memory");
  __builtin_amdgcn_s_barrier();
  if (half == 1) __builtin_amdgcn_s_barrier();
#pragma nounroll
  for (int kt = 0; kt < nk; ++kt) {
    __builtin_amdgcn_s_barrier();
    if (kt + 3 < nk) { GC_PIECE(kt + 3, 0); GC_PIECE(kt + 3, 1); GC_PIECE(kt + 3, 2); GC_PIECE(kt + 3, 3); GC_PIECE(kt + 3, 4); }
    const unsigned sa_addr = lds0 + (kt & 3) * 34816 + half * 9216 + fo;
    const unsigned sb_addr = lds0 + (kt & 3) * 34816 + 18432 + wn * 4096 + fo;
    bf16x8 af[9], bfr[4];
    asm volatile(
        "ds_read_b128 %0, %14\n\t"
        "ds_read_b128 %1, %14 offset:1024\n\t"
        "ds_read_b128 %2, %14 offset:2048\n\t"
        "ds_read_b128 %3, %14 offset:3072\n\t"
        "ds_read_b128 %4, %13\n\t"
        "ds_read_b128 %5, %13 offset:1024\n\t"
        "ds_read_b128 %6, %13 offset:2048\n\t"
        "ds_read_b128 %7, %13 offset:3072\n\t"
        "ds_read_b128 %8, %13 offset:4096\n\t"
        "ds_read_b128 %9, %13 offset:5120\n\t"
        "ds_read_b128 %10, %13 offset:6144\n\t"
        "ds_read_b128 %11, %13 offset:7168\n\t"
        "ds_read_b128 %12, %13 offset:8192"
        : "=&v"(bfr[0]), "=&v"(bfr[1]), "=&v"(bfr[2]), "=&v"(bfr[3]), "=&v"(af[0]), "=&v"(af[1]), "=&v"(af[2]), "=&v"(af[3]), "=&v"(af[4]),
          "=&v"(af[5]), "=&v"(af[6]), "=&v"(af[7]), "=&v"(af[8])
        : "v"(sa_addr), "v"(sb_addr) : "memory");
    if (kt + 3 < nk) { if (w < 2) asm volatile("s_waitcnt vmcnt(10)" ::: "memory"); else asm volatile("s_waitcnt vmcnt(8)" ::: "memory"); }
    else if (kt + 2 < nk) { if (w < 2) asm volatile("s_waitcnt vmcnt(5)" ::: "memory"); else asm volatile("s_waitcnt vmcnt(4)" ::: "memory"); }
    else asm volatile("s_waitcnt vmcnt(0)" ::: "memory");
    asm volatile("s_waitcnt lgkmcnt(0)"
                 : "+v"(bfr[0]), "+v"(bfr[1]), "+v"(bfr[2]), "+v"(bfr[3]), "+v"(af[0]), "+v"(af[1]), "+v"(af[2]), "+v"(af[3]), "+v"(af[4]),
                   "+v"(af[5]), "+v"(af[6]), "+v"(af[7]), "+v"(af[8]) :: "memory");
    __builtin_amdgcn_s_barrier();
#define GC_WAIT(n_, v_) asm volatile("s_waitcnt lgkmcnt(" #n_ ")" : "+v"(v_))
#define GC_ROW(m_) _Pragma("unroll") for (int n = 0; n < 4; ++n) acc[m_][n] = __builtin_amdgcn_mfma_f32_16x16x32_bf16(bfr[n], af[m_], acc[m_][n], 0, 0, 0)
    GC_ROW(0); GC_ROW(1); GC_ROW(2); GC_ROW(3); GC_ROW(4); GC_ROW(5); GC_ROW(6); GC_ROW(7); GC_ROW(8);
  }
  if (half == 0) __builtin_amdgcn_s_barrier();
  __syncthreads();
  const int row0 = tm * 288 + half * 144 + fr, col0 = tn * 256 + wn * 64 + fq * 4;
  if (g.mode <= 1) {
    const int odd = fq & 1;
    const int cpair = odd ? 16 + (fq - 1) * 4 : fq * 4;
    const int nko = g.ldo >> 5;
#pragma unroll
    for (int m = 0; m < 9; ++m) {
      uint2 o[4];
      const float rs2 = (g.mode == 1 && g.rss) ? 1.0f / (g.rss[row0 + m * 16] * (1.0f / 2048.0f) + EPS) : 1.0f;
#pragma unroll
      for (int n = 0; n < 4; ++n) {
        f32x4 v = acc[m][n];
        if (g.mode == 1) {
#pragma unroll
          for (int j = 0; j < 4; ++j) { const float r = fmaxf(v[j], 0.f); v[j] = r * r * rs2; }
        }
        o[n].x = pack2(v[0], v[1]); o[n].y = pack2(v[2], v[3]);
      }
      bf16_t* rowp = g.oblk ? g.ob + ((size_t)tm * nko * 288 + (size_t)(half * 144 + m * 16 + fr)) * 32
                            : g.ob + (size_t)(row0 + m * 16) * g.ldo;
#pragma unroll
      for (int j = 0; j < 2; ++j) {
        const uint2 keep = odd ? o[2 * j + 1] : o[2 * j];
        const uint2 send = odd ? o[2 * j] : o[2 * j + 1];
        uint2 recv; recv.x = __shfl_xor(send.x, 16); recv.y = __shfl_xor(send.y, 16);
        const uint4 wv = odd ? make_uint4(recv.x, recv.y, keep.x, keep.y) : make_uint4(keep.x, keep.y, recv.x, recv.y);
        const int col = tn * 256 + wn * 64 + j * 32 + cpair;
        if (g.oblk) *(uint4*)(rowp + (size_t)(col >> 5) * 9216 + (col & 31)) = wv;
        else *(uint4*)(rowp + col) = wv;
      }
    }
  } else if (g.mode == 2) {
    f32x4 gv[4];
#pragma unroll
    for (int n = 0; n < 4; ++n) gv[n] = *(const f32x4*)(g.gain + col0 + n * 16);
    const int odd2 = fq & 1;
    const int cpair2 = odd2 ? 16 + (fq - 1) * 4 : fq * 4;
#pragma unroll
    for (int m = 0; m < 9; ++m) {
      const int row = row0 + m * 16;
      const float* xr = (row < NPT ? p.xp + (size_t)row * 2048 : p.xs + (size_t)(row - NPT) * 2048) + col0;
      float* hr = p.out + (size_t)row * 2048 + col0;
      uint2 hb[4];
      float ss = 0.f;
#pragma unroll
      for (int n = 0; n < 4; ++n) {
        const float4 x = *(const float4*)(xr + n * 16);
        float4 o; o.x = x.x + acc[m][n][0]; o.y = x.y + acc[m][n][1]; o.z = x.z + acc[m][n][2]; o.w = x.w + acc[m][n][3];
        *(float4*)(hr + n * 16) = o;
        ss += o.x * o.x + o.y * o.y + o.z * o.z + o.w * o.w;
        hb[n].x = pack2(o.x * gv[n][0], o.y * gv[n][1]); hb[n].y = pack2(o.z * gv[n][2], o.w * gv[n][3]);
      }
      ss += __shfl_xor(ss, 16); ss += __shfl_xor(ss, 32);
      if (fq == 0) unsafeAtomicAdd(g.rss + row, ss);
      bf16_t* rowp = g.ob + ((size_t)tm * 64 * 288 + (size_t)(half * 144 + m * 16 + fr)) * 32;
#pragma unroll
      for (int j = 0; j < 2; ++j) {
        const uint2 keep = odd2 ? hb[2 * j + 1] : hb[2 * j];
        const uint2 send = odd2 ? hb[2 * j] : hb[2 * j + 1];
        uint2 recv; recv.x = __shfl_xor(send.x, 16); recv.y = __shfl_xor(send.y, 16);
        const uint4 wv = odd2 ? make_uint4(recv.x, recv.y, keep.x, keep.y) : make_uint4(keep.x, keep.y, recv.x, recv.y);
        const int col = tn * 256 + wn * 64 + j * 32 + cpair2;
        *(uint4*)(rowp + (size_t)(col >> 5) * 9216 + (col & 31)) = wv;
      }
      asm volatile("" ::: "memory");
    }
  } else {
#pragma unroll
    for (int m = 0; m < 9; ++m) {
      float* hr = p.out + (size_t)(row0 + m * 16) * 2048 + col0;
#pragma unroll
      for (int n = 0; n < 4; ++n) {
        float4 x = *(const float4*)(hr + n * 16);
        x.x += acc[m][n][0]; x.y += acc[m][n][1]; x.z += acc[m][n][2]; x.w += acc[m][n][3];
        *(float4*)(hr + n * 16) = x;
      }
      asm volatile("" ::: "memory");
    }
  }
}

DI void run_gemm_c(const Params& p, const GemmArgs& g, char* smem_all) {
  const int PN = g.TN >> 3, total = g.TM * g.TN, nb = gridDim.x, b = blockIdx.x;
  for (int it = 0; it * nb < total; ++it) {
    const int L = ((nb & 7) == 0) ? it * nb + (b & 7) * (nb >> 3) + (b >> 3) : it * nb + b;
    if (L >= total) continue;
    const int pidx = L >> 5, j = L & 31;
    const int tm = (pidx / PN) * 4 + (j & 3), tn = (pidx % PN) * 8 + (j >> 2);
    gemm_tile_c(p, g, tm, tn, smem_all);
  }
}

DI void run_gemm_b(const Params& p, const GemmArgs& g, char* smem) {
  const int PN = g.TN >> 3, total = g.TM * g.TN;
  for (int it = 0; it * NVB < total; ++it) {
    const int L = slot_index(it);
    if (L >= total) continue;
    const int pidx = L >> 6, j = L & 63;
    const int tm = (pidx / PN) * 8 + (j & 7), tn = (pidx % PN) * 8 + (j >> 3);
    gemm_tile_b(p, g, tm, tn, smem);
  }
}

DI void run_gemm(const Params& p, const GemmArgs& g, char* smem) {
  const int PM = (g.TM + 7) >> 3, PN = (g.TN + 7) >> 3, total = PM * PN * 64;
  for (int it = 0;; ++it) {
    const int L = slot_index(it);
    if (it * NVB >= total) break;
    if (L >= total) continue;
    const int pidx = L >> 6, j = L & 63;
    const int tm = (pidx / PN) * 8 + (j & 7), tn = (pidx % PN) * 8 + (j >> 3);
    if (tm < g.TM && tn < g.TN) gemm_tile(p, g, tm, tn, smem);
  }
}

DI void gate_item(const Params& p, int ci, int g, char* smem) {
  const int tid = VTID, lane = tid & 63, wid = tid >> 6, wr = wid >> 1, wc = wid & 1, fr = lane & 15, fq = lane >> 4;
  const bool samp = ci >= 64;
  const int tok0 = ci * 128;
  const bf16_t* Wg = (const bf16_t*)(p.ws + (samp ? WS_WSPS : WS_WSPP)) + (size_t)g * 16384;
  bf16_t* U = (bf16_t*)((char*)p.out + DO_U);
  const bf16_t* V = (const bf16_t*)((char*)p.out + DO_V);
  f32x4 acc[4][4];
#pragma unroll
  for (int m = 0; m < 4; ++m)
#pragma unroll
    for (int n = 0; n < 4; ++n) acc[m][n] = (f32x4){0.f, 0.f, 0.f, 0.f};
  const int lrow = tid >> 3, lch = tid & 7;
  for (int ks = 0; ks < 2; ++ks) {
#pragma unroll
    for (int i = 0; i < 4; ++i) {
      const uint4 d = *(const uint4*)(Wg + (size_t)(lrow + 32 * i) * 128 + ks * 64 + lch * 8);
      *(uint4*)(smem + lds_byte(lrow + 32 * i, lch * 8)) = d;
    }
    const int sl = tid & 63, c0 = tid >> 6;
#pragma unroll
    for (int i = 0; i < 4; ++i) {
      const int cc = c0 + 4 * i;
      const uint4 d = *(const uint4*)(V + (size_t)(tok0 + ks * 64 + sl) * 1024 + g * 128 + cc * 8);
      const unsigned w[4] = {d.x, d.y, d.z, d.w};
#pragma unroll
      for (int e = 0; e < 8; ++e) {
        const bf16_t val = (bf16_t)((e & 1) ? (w[e >> 1] >> 16) : (w[e >> 1] & 0xffffu));
        *(bf16_t*)(smem + 16384 + lds_byte(cc * 8 + e, sl)) = val;
      }
    }
    __syncthreads();
    mma_kstep(smem, smem + 16384, acc, wr, wc, fr, fq);
    __syncthreads();
  }
#pragma unroll
  for (int m = 0; m < 4; ++m) {
    const int t = wr * 64 + m * 16 + fr;
    const float bias = p.b_spatial[g * 128 + (samp ? (t & 31) : t)];
    bf16_t* up = U + (size_t)(tok0 + t) * 1024 + g * 128 + wc * 64 + fq * 4;
#pragma unroll
    for (int n = 0; n < 4; ++n) {
      const uint2 uu = *(const uint2*)(up + n * 16);
      uint2 o;
      o.x = pack2(bflo(uu.x) * (acc[m][n][0] + bias), bfhi(uu.x) * (acc[m][n][1] + bias));
      o.y = pack2(bflo(uu.y) * (acc[m][n][2] + bias), bfhi(uu.y) * (acc[m][n][3] + bias));
      *(uint2*)(up + n * 16) = o;
    }
  }
}

DI void phase_rowops_a(const Params& p) {
  const int lane = VTID & 63, wid = VTID >> 6;
  const bf16_t* Z = (const bf16_t*)(p.ws + WS_Z);
  bf16_t* QN = (bf16_t*)(p.ws + WS_QN);
  bf16_t* U = (bf16_t*)((char*)p.out + DO_U);
  bf16_t* V = (bf16_t*)((char*)p.out + DO_V);
  bf16_t* ALLC = (bf16_t*)((char*)p.out + DO_ALLC);
  bf16_t* ALLPE = (bf16_t*)((char*)p.out + DO_ALLPE);
  const float2* ROPE = (const float2*)(p.ws + WS_ROPE);
  for (int r = VB * 4 + wid; r < NTOK; r += NVB * 4) {
    const bf16_t* zr = Z + (size_t)r * ZLD;
    const bool samp = r >= NPT;
    const int s = r - NPT;
    const int keyrow = samp ? NPT + (s >> 5) * 1056 + 1024 + (s & 31) : r;
    const int pos = samp ? 1024 + (s & 31) : (r & 2047);
    float f[8];
    {
      unpack8(*(const uint4*)(zr + 8 * lane), f);
      float ss = 0.f;
#pragma unroll
      for (int i = 0; i < 8; ++i) ss += f[i] * f[i];
      ss = wave_sum(ss);
      const float rs = rsqrtf(ss * (1.0f / 512.0f) + EPS);
      const float4 g0 = *(const float4*)(p.q_lat_norm + 8 * lane), g1 = *(const float4*)(p.q_lat_norm + 8 * lane + 4);
      const float gg[8] = {g0.x, g0.y, g0.z, g0.w, g1.x, g1.y, g1.z, g1.w};
#pragma unroll
      for (int i = 0; i < 8; ++i) f[i] = f[i] * rs * gg[i];
      *(uint4*)(QN + (size_t)r * 512 + 8 * lane) = pack8(f);
    }
    {
      const uint2 d = *(const uint2*)(zr + 512 + 4 * lane);
      float c[4] = {bflo(d.x), bfhi(d.x), bflo(d.y), bfhi(d.y)};
      float ss = c[0] * c[0] + c[1] * c[1] + c[2] * c[2] + c[3] * c[3];
      ss = wave_sum(ss);
      const float rs = rsqrtf(ss * (1.0f / 256.0f) + EPS);
      const float4 g = *(const float4*)(p.kv_lat_norm + 4 * lane);
      float4 o; o.x = c[0] * rs * g.x; o.y = c[1] * rs * g.y; o.z = c[2] * rs * g.z; o.w = c[3] * rs * g.w;
      float* dst = samp ? p.out + O_CKVS + (size_t)s * 256 : p.out + O_CKVP + (size_t)r * 256;
      *(float4*)(dst + 4 * lane) = o;
      uint2 ob; ob.x = pack2(o.x, o.y); ob.y = pack2(o.z, o.w);
      *(uint2*)(ALLC + (size_t)keyrow * 256 + 4 * lane) = ob;
    }
    if (lane < 32) {
      const float x1 = bflo((unsigned)zr[768 + lane]), x2 = bflo((unsigned)zr[800 + lane]);
      const float2 cs = ROPE[pos * 32 + lane];
      const float o1 = x1 * cs.x - x2 * cs.y, o2 = x1 * cs.y + x2 * cs.x;
      float* dst = samp ? p.out + O_KPES + (size_t)s * 64 : p.out + O_KPEP + (size_t)r * 64;
      dst[lane] = o1; dst[32 + lane] = o2;
      ALLPE[(size_t)keyrow * 64 + lane] = (bf16_t)(pack2(o1, 0.f) & 0xffffu);
      ALLPE[(size_t)keyrow * 64 + 32 + lane] = (bf16_t)(pack2(o2, 0.f) & 0xffffu);
    }
#pragma unroll
    for (int it = 0; it < 2; ++it) {
      unpack8(*(const uint4*)(zr + 832 + it * 512 + 8 * lane), f);
#pragma unroll
      for (int i = 0; i < 8; ++i) f[i] = gelu_tanh(f[i]);
      *(uint4*)(U + (size_t)r * 1024 + it * 512 + 8 * lane) = pack8(f);
    }
#pragma unroll
    for (int it = 0; it < 2; ++it) {
      unpack8(*(const uint4*)(zr + 1856 + it * 512 + 8 * lane), f);
      float ss = 0.f;
#pragma unroll
      for (int i = 0; i < 8; ++i) { f[i] = gelu_tanh(f[i]); ss += f[i] * f[i]; }
      ss = grp_sum(ss, 16);
      const float rs = rsqrtf(ss * (1.0f / 128.0f) + EPS);
      const int ch = it * 512 + 8 * lane;
      const float4 g0 = *(const float4*)(p.v_norm + ch), g1 = *(const float4*)(p.v_norm + ch + 4);
      const float gg[8] = {g0.x, g0.y, g0.z, g0.w, g1.x, g1.y, g1.z, g1.w};
#pragma unroll
      for (int i = 0; i < 8; ++i) f[i] = f[i] * rs * gg[i];
      *(uint4*)(V + (size_t)r * 1024 + ch) = pack8(f);
      if (samp) {
        float* dst = p.out + O_VS + (size_t)s * 1024 + ch;
        *(float4*)dst = make_float4(f[0], f[1], f[2], f[3]);
        *(float4*)(dst + 4) = make_float4(f[4], f[5], f[6], f[7]);
      }
    }
  }
}

DI void phase_rowops_b(const Params& p) {
  const int lane = VTID & 63, wid = VTID >> 6;
  const int hd = lane >> 3, sub = lane & 7;
  bf16_t* Q = (bf16_t*)(p.ws + WS_A);
  const float2* ROPE = (const float2*)(p.ws + WS_ROPE);
  const float SC = 0.07216878364870323f * 1.4426950408889634f;
  const int nw = NVB * 4, w0 = VB * 4 + wid;
  for (int r = w0; r < NTOK; r += nw) {
    const int pos = r >= NPT ? 1024 + ((r - NPT) & 31) : (r & 2047);
    bf16_t* qb = Q + (size_t)r * 1536 + hd * 192;
    float a[16], x1[4], x2[4];
    unpack8(*(const uint4*)(qb + 16 * sub), a);
    unpack8(*(const uint4*)(qb + 16 * sub + 8), a + 8);
    { const uint2 d = *(const uint2*)(qb + 128 + 4 * sub); x1[0] = bflo(d.x); x1[1] = bfhi(d.x); x1[2] = bflo(d.y); x1[3] = bfhi(d.y); }
    { const uint2 d = *(const uint2*)(qb + 160 + 4 * sub); x2[0] = bflo(d.x); x2[1] = bfhi(d.x); x2[2] = bflo(d.y); x2[3] = bfhi(d.y); }
    float ss = 0.f;
#pragma unroll
    for (int i = 0; i < 16; ++i) ss += a[i] * a[i];
    float o1[4], o2[4];
#pragma unroll
    for (int j = 0; j < 4; ++j) {
      const float2 cs = ROPE[pos * 32 + 4 * sub + j];
      o1[j] = x1[j] * cs.x - x2[j] * cs.y; o2[j] = x1[j] * cs.y + x2[j] * cs.x;
      ss += o1[j] * o1[j] + o2[j] * o2[j];
    }
    ss = grp_sum(ss, 8);
    const float rs = rsqrtf(ss * (1.0f / 192.0f) + EPS) * SC;
#pragma unroll
    for (int i = 0; i < 16; ++i) a[i] = a[i] * rs * p.q_norm_nope[16 * sub + i] * p.k_norm_nope[16 * sub + i];
#pragma unroll
    for (int j = 0; j < 4; ++j) {
      const float gg = p.q_norm_rope[4 * sub + j] * p.k_norm_rope[4 * sub + j] * rs;
      o1[j] *= gg; o2[j] *= gg;
    }
    *(uint4*)(qb + 16 * sub) = pack8(a);
    *(uint4*)(qb + 16 * sub + 8) = pack8(a + 8);
    { uint2 o; o.x = pack2(o1[0], o1[1]); o.y = pack2(o1[2], o1[3]); *(uint2*)(qb + 128 + 4 * sub) = o; }
    { uint2 o; o.x = pack2(o2[0], o2[1]); o.y = pack2(o2[2], o2[3]); *(uint2*)(qb + 160 + 4 * sub) = o; }
  }
  const bf16_t* ALLPE = (const bf16_t*)((const char*)p.out + DO_ALLPE);
  float* RSK = (float*)(p.ws + WS_RSK);
  for (int kr = VB * 256 + VTID; kr < NKEY; kr += NVB * 256) {
    float e[8], ss = 0.f;
#pragma unroll
    for (int c = 0; c < 8; ++c) {
      unpack8(*(const uint4*)(ALLPE + (size_t)kr * 64 + 8 * c), e);
#pragma unroll
      for (int i = 0; i < 8; ++i) ss += e[i] * e[i];
    }
    float4 r0 = *(const float4*)(RSK + (size_t)kr * 8), r1 = *(const float4*)(RSK + (size_t)kr * 8 + 4);
    r0.x = rsqrtf((r0.x + ss) * (1.0f / 192.0f) + EPS); r0.y = rsqrtf((r0.y + ss) * (1.0f / 192.0f) + EPS);
    r0.z = rsqrtf((r0.z + ss) * (1.0f / 192.0f) + EPS); r0.w = rsqrtf((r0.w + ss) * (1.0f / 192.0f) + EPS);
    r1.x = rsqrtf((r1.x + ss) * (1.0f / 192.0f) + EPS); r1.y = rsqrtf((r1.y + ss) * (1.0f / 192.0f) + EPS);
    r1.z = rsqrtf((r1.z + ss) * (1.0f / 192.0f) + EPS); r1.w = rsqrtf((r1.w + ss) * (1.0f / 192.0f) + EPS);
    *(float4*)(RSK + (size_t)kr * 8) = r0; *(float4*)(RSK + (size_t)kr * 8 + 4) = r1;
  }
}

DI void attn_item(const Params& p, int item, char* smem) {
  const int tid = VTID, lane = tid & 63, wid = tid >> 6, hh = lane >> 5, lq = lane & 31;
  bool samp; int b, h, qt = 0;
  if (item < 256) { samp = false; qt = 15 - (item >> 5); b = (item & 31) >> 3; h = item & 7; }
  else if (item < 512) { samp = true; b = (item - 256) >> 3; h = item & 7; }
  else { samp = false; qt = 7 - ((item - 512) >> 5); b = (item & 31) >> 3; h = item & 7; }
  int kb, ntiles, tok, mynt;
  if (!samp) { kb = b * 2048; ntiles = 2 * qt + 2; tok = b * 2048 + qt * 128 + wid * 32 + lq; mynt = 2 * qt + 1 + (wid >> 1); }
  else { kb = NPT + b * 1056; ntiles = 17; tok = NPT + b * 32 + lq; mynt = wid == 0 ? 17 : (wid == 1 ? 16 : 0); }
  const int submask_all = samp ? (wid == 0 ? 1 : 2) : 3;

  const bf16_t* Q = (const bf16_t*)(p.ws + WS_A);
  const bf16_t* KN = (const bf16_t*)(p.ws + WS_KN);
  const bf16_t* VT = (const bf16_t*)(p.ws + WS_VT);
  const bf16_t* ALLPE = (const bf16_t*)((const char*)p.out + DO_ALLPE);
  const float* RSK = (const float*)(p.ws + WS_RSK);
  bf16_t* AO = (bf16_t*)((char*)p.out + DO_V);

  bf16x8 qf[12];
  {
    const bf16_t* qp = Q + (size_t)tok * 1536 + h * 192 + 8 * hh;
#pragma unroll
    for (int s = 0; s < 12; ++s) qf[s] = *(const bf16x8*)(qp + 16 * s);
  }
  f32x16 o[4];
#pragma unroll
  for (int d = 0; d < 4; ++d)
#pragma unroll
    for (int i = 0; i < 16; ++i) o[d][i] = 0.f;
  float m = -INFINITY, l = 0.f;

  char* Kl = smem;
  char* Vl = smem + 25600;
  float* Rl = (float*)(smem + 43008);

  const bf16_t* kn_g = KN + ((size_t)h * NKEYP + kb + (tid >> 4)) * 128 + (tid & 15) * 8;
  const bf16_t* pe_g = ALLPE + (size_t)(kb + (tid >> 3)) * 64 + (tid & 7) * 8;
  const bf16_t* vt_g = VT + (size_t)(h * 128 + (tid >> 3)) * NKEYP + kb + (tid & 7) * 8;
  const float* rs_g = RSK + (size_t)(kb + (tid & 63)) * 8 + h;
  uint4 skn0, skn1, skn2, skn3, spe0, spe1, svt0, svt1, svt2, svt3; float srs = 0.f;
#define ATT_GLOAD(t) do { \
    const bf16_t* k_ = kn_g + (size_t)(t) * 8192; \
    skn0 = *(const uint4*)(k_); skn1 = *(const uint4*)(k_ + 2048); skn2 = *(const uint4*)(k_ + 4096); skn3 = *(const uint4*)(k_ + 6144); \
    const bf16_t* p_ = pe_g + (size_t)(t) * 4096; \
    spe0 = *(const uint4*)(p_); spe1 = *(const uint4*)(p_ + 2048); \
    const bf16_t* v_ = vt_g + (size_t)(t) * 64; \
    svt0 = *(const uint4*)(v_); svt1 = *(const uint4*)(v_ + (size_t)32 * NKEYP); svt2 = *(const uint4*)(v_ + (size_t)64 * NKEYP); svt3 = *(const uint4*)(v_ + (size_t)96 * NKEYP); \
    if (tid < 64) srs = rs_g[(size_t)(t) * 512]; } while (0)
  ATT_GLOAD(0);
  for (int t = 0; t < ntiles; ++t) {
    __syncthreads();
    {
      char* kd = Kl + (tid >> 4) * 400 + (tid & 15) * 16;
      *(uint4*)(kd) = skn0; *(uint4*)(kd + 6400) = skn1; *(uint4*)(kd + 12800) = skn2; *(uint4*)(kd + 19200) = skn3;
      char* pd = Kl + (tid >> 3) * 400 + 256 + (tid & 7) * 16;
      *(uint4*)(pd) = spe0; *(uint4*)(pd + 12800) = spe1;
      char* vd = Vl + (tid >> 3) * 136 + (tid & 7) * 16;
      *(uint2*)(vd) = make_uint2(svt0.x, svt0.y); *(uint2*)(vd + 8) = make_uint2(svt0.z, svt0.w);
      *(uint2*)(vd + 4352) = make_uint2(svt1.x, svt1.y); *(uint2*)(vd + 4360) = make_uint2(svt1.z, svt1.w);
      *(uint2*)(vd + 8704) = make_uint2(svt2.x, svt2.y); *(uint2*)(vd + 8712) = make_uint2(svt2.z, svt2.w);
      *(uint2*)(vd + 13056) = make_uint2(svt3.x, svt3.y); *(uint2*)(vd + 13064) = make_uint2(svt3.z, svt3.w);
    }
    if (tid < 64) Rl[tid] = srs;
    __syncthreads();
    if (t + 1 < ntiles) ATT_GLOAD(t + 1);
    if (t < mynt) {
#pragma unroll
      for (int sub = 0; sub < 2; ++sub) {
        if (!((submask_all >> sub) & 1)) continue;
        f32x16 sc;
#pragma unroll
        for (int i = 0; i < 16; ++i) sc[i] = 0.f;
        const char* kp = Kl + (32 * sub + lq) * 400 + hh * 16;
#pragma unroll
        for (int s = 0; s < 12; ++s) {
          const bf16x8 kf = *(const bf16x8*)(kp + 32 * s);
          sc = __builtin_amdgcn_mfma_f32_32x32x16_bf16(kf, qf[s], sc, 0, 0, 0);
        }
        float mloc = -INFINITY;
#pragma unroll
        for (int g = 0; g < 4; ++g) {
          const f32x4 r4 = *(const f32x4*)(Rl + 32 * sub + 8 * g + 4 * hh);
#pragma unroll
          for (int j = 0; j < 4; ++j) { sc[4 * g + j] *= r4[j]; mloc = fmaxf(mloc, sc[4 * g + j]); }
        }
        mloc = fmaxf(mloc, __shfl_xor(mloc, 32));
        const float mn = fmaxf(m, mloc);
        const float alpha = __builtin_amdgcn_exp2f(m - mn);
        m = mn;
        float ps = 0.f;
#pragma unroll
        for (int i = 0; i < 16; ++i) { sc[i] = __builtin_amdgcn_exp2f(sc[i] - mn); ps += sc[i]; }
        l = l * alpha + ps;
#pragma unroll
        for (int d = 0; d < 4; ++d)
#pragma unroll
          for (int i = 0; i < 16; ++i) o[d][i] *= alpha;
        bf16x8 pf[2];
#pragma unroll
        for (int s2 = 0; s2 < 2; ++s2) {
          u32x4 pu;
#pragma unroll
          for (int j = 0; j < 4; ++j) pu[j] = pack2(sc[8 * s2 + 2 * j], sc[8 * s2 + 2 * j + 1]);
          pf[s2] = __builtin_bit_cast(bf16x8, pu);
        }
#pragma unroll
        for (int s2 = 0; s2 < 2; ++s2)
#pragma unroll
          for (int d = 0; d < 4; ++d) {
            const char* vp = Vl + (32 * d + lq) * 136 + (32 * sub + 16 * s2 + 4 * hh) * 2;
            const s16x4 lo = *(const s16x4*)vp, hi = *(const s16x4*)(vp + 16);
            const bf16x8 vf = __builtin_shufflevector(lo, hi, 0, 1, 2, 3, 4, 5, 6, 7);
            o[d] = __builtin_amdgcn_mfma_f32_32x32x16_bf16(vf, pf[s2], o[d], 0, 0, 0);
          }
      }
    }
  }
  if (samp) {
    __syncthreads();
    float* Ml = (float*)smem;
    if (wid == 1) {
      Ml[lane] = m; Ml[64 + lane] = l;
#pragma unroll
      for (int d = 0; d < 4; ++d)
#pragma unroll
        for (int i = 0; i < 16; ++i) Ml[(2 + d * 16 + i) * 64 + lane] = o[d][i];
    }
    __syncthreads();
    if (wid == 0) {
      const float m1 = Ml[lane], l1 = Ml[64 + lane];
      const float mn = fmaxf(m, m1);
      const float a0 = __builtin_amdgcn_exp2f(m - mn), a1 = __builtin_amdgcn_exp2f(m1 - mn);
      l = l * a0 + l1 * a1;
#pragma unroll
      for (int d = 0; d < 4; ++d)
#pragma unroll
        for (int i = 0; i < 16; ++i) o[d][i] = o[d][i] * a0 + Ml[(2 + d * 16 + i) * 64 + lane] * a1;
    }
  }
  if (!samp || wid == 0) {
    const float lt = l + __shfl_xor(l, 32);
    const float inv = 1.0f / lt;
    bf16_t* op = AO + (size_t)tok * 1024 + h * 128 + 4 * hh;
#pragma unroll
    for (int d = 0; d < 4; ++d)
#pragma unroll
      for (int g = 0; g < 4; ++g) {
        uint2 ov; ov.x = pack2(o[d][4 * g] * inv, o[d][4 * g + 1] * inv); ov.y = pack2(o[d][4 * g + 2] * inv, o[d][4 * g + 3] * inv);
        *(uint2*)(op + 32 * d + 8 * g) = ov;
      }
  }
}

DI void phase_attn(const Params& p, char* smem, int* s_pair) {
  unsigned* cnt = (unsigned*)(p.ws + WS_CNT);
  for (;;) {
    __syncthreads();
    if (threadIdx.x == 0) s_pair[0] = (int)atomicAdd(cnt, 2u);
    __syncthreads();
    const int base = s_pair[0];
    if (base >= 768) break;
    attn_item(p, base + VHALF, smem);
  }
  unsigned* cnt2 = cnt + 32;
  for (;;) {
    __syncthreads();
    if (threadIdx.x == 0) s_pair[0] = (int)atomicAdd(cnt2, 2u);
    __syncthreads();
    const int base = s_pair[0];
    if (base >= 2304) break;
    const int grp = base + VHALF;
#pragma unroll 1
    for (int q = 0; q < 4; ++q) {
      const int j = grp * 4 + q;
      if (j >= 8192) { const int t = j - 8192; transpose_tile_blk(p.w_out, 2048, (bf16_t*)(p.ws + WS_WOUT), 64, (t / 32) * 64, (t % 32) * 64, (float*)smem); }
      else if (j < 4096) transpose_tile_blk(p.w_up, 8192, (bf16_t*)(p.ws + WS_WUP), 64, (j / 128) * 64, (j % 128) * 64, (float*)smem);
      else { const int t = j - 4096; transpose_tile_blk(p.w_down, 2048, (bf16_t*)(p.ws + WS_WDN), 256, (t / 32) * 64, (t % 32) * 64, (float*)smem); }
    }
  }
}

DI void phase_rowops_c(const Params& p, char* smem) {
  const int lane = VTID & 63, wid = VTID >> 6;
  const bf16_t* AO = (const bf16_t*)((const char*)p.out + DO_V);
  const bf16_t* GO = (const bf16_t*)((const char*)p.out + DO_U);
  bf16_t* M = (bf16_t*)(p.ws + WS_BIG);
  for (int r = VB * 4 + wid; r < NTOK; r += NVB * 4) {
#pragma unroll
    for (int half = 0; half < 2; ++half) {
      const bf16_t* src = (half ? GO : AO) + (size_t)r * 1024;
      const float* gain = half ? p.out_norm_gmlp : p.out_norm_attn;
      float f[16];
      unpack8(*(const uint4*)(src + 8 * lane), f);
      unpack8(*(const uint4*)(src + 512 + 8 * lane), f + 8);
      float ss = 0.f;
#pragma unroll
      for (int i = 0; i < 16; ++i) ss += f[i] * f[i];
      ss = wave_sum(ss);
      const float rs = rsqrtf(ss * (1.0f / 1024.0f) + EPS);
#pragma unroll
      for (int i = 0; i < 8; ++i) { f[i] = f[i] * rs * gain[8 * lane + i]; f[8 + i] = f[8 + i] * rs * gain[512 + 8 * lane + i]; }
      const int tmr = r / 288, rr = r - tmr * 288;
      const int c0 = half * 1024 + 8 * lane, c1 = c0 + 512;
      *(uint4*)(M + ((size_t)(tmr * 64 + (c0 >> 5)) * 288 + rr) * 32 + (c0 & 31)) = pack8(f);
      *(uint4*)(M + ((size_t)(tmr * 64 + (c1 >> 5)) * 288 + rr) * 32 + (c1 & 31)) = pack8(f + 8);
    }
  }
}

__global__ void __launch_bounds__(512, 2) hymba_megakernel(Params p) {
  __shared__ __attribute__((aligned(16))) char smem_all[153600];
  __shared__ int s_pair[4];
  char* smem = smem_all + VHALF * 76800;
  const int lo = p.phase_lo, hi = p.phase_hi;
  __shared__ uint4 xb_words;
  if (threadIdx.x == 0) xb_words = make_uint4(0u, 0u, 0u, 0u);
  __syncthreads();
  XcdBarrier xb; xb.bar = (unsigned*)(p.ws + WS_BAR); xb.x = 0; xb.st = (volatile LAS unsigned*)&xb_words;
  if (p.coop) xb = xcd_barrier_post((unsigned*)(p.ws + WS_BAR), (volatile LAS unsigned*)&xb_words);
#ifndef PH_MASK
#define PH_MASK 0x7ff
#endif
#define PH_BEGIN(n) if (lo <= (n) && (n) < hi) { if ((n) > lo && p.coop) { if (p.coop == 2) cg::this_grid().sync(); else xcd_barrier(xb); } if ((PH_MASK >> (n)) & 1) {
#define PH_END }}
#ifndef PROBE_DUP
#define PROBE_DUP 0
#endif
  PH_BEGIN(0) phase_prep(p, smem, 0, VB, NVB); PH_END
  PH_BEGIN(1)
    GemmArgs g; g.rss = nullptr; g.gain = nullptr; g.blk = 0; g.oblk = 0; g.A = (const bf16_t*)(p.ws + WS_A); g.lda = 2048; g.B = (const bf16_t*)(p.ws + WS_WIN); g.ldb = 2048;
    g.TM = 32; g.TN = 12; g.K = 2048; g.mode = 0; g.ob = (bf16_t*)(p.ws + WS_Z); g.ldo = ZLD; g.blk = 1;
    {
      const int nb = gridDim.x, b = blockIdx.x, total = 8 * 2 * 32;
      for (int it = 0; it * nb < total; ++it) {
        const int L = ((nb & 7) == 0) ? it * nb + (b & 7) * (nb >> 3) + (b >> 3) : it * nb + b;
        if (L >= total) continue;
        const int pidx = L >> 5, j = L & 31, pm = pidx >> 1, pn = pidx & 1;
        const int tm = pm * 4 + (j & 3), tn = pn * 8 + (j >> 2);
        if (tn < 12) gemm_tile_c(p, g, tm, tn, smem_all);
        else phase_prep(p, smem, 1, (pm * 16 + (j - 16)) * 2 + VHALF, 256);
      }
    }
  PH_END
  PH_BEGIN(2) phase_rowops_a(p); if ((PROBE_DUP >> 2) & 1) { xcd_barrier(xb); phase_rowops_a(p); } PH_END
  PH_BEGIN(3)
    GemmArgs g; g.rss = nullptr; g.gain = nullptr; g.blk = 0; g.oblk = 0;
    g.A = (const bf16_t*)(p.ws + WS_QN); g.lda = 512; g.B = (const bf16_t*)(p.ws + WS_WUQ); g.ldb = 512;
    g.TM = 72; g.TN = 12; g.K = 512; g.mode = 0; g.ob = (bf16_t*)(p.ws + WS_A); g.ldo = 1536;
    run_gemm(p, g, smem);
    g.A = (const bf16_t*)((const char*)p.out + DO_ALLC); g.lda = 256; g.B = (const bf16_t*)(p.ws + WS_WUK); g.ldb = 256;
    g.TM = 328; g.TN = 8; g.K = 256; g.mode = 0; g.ob = (bf16_t*)(p.ws + WS_KN); g.ldo = 1024; g.rss = (float*)(p.ws + WS_RSK); g.oblk = 2;
    run_gemm(p, g, smem);
    g.rss = nullptr; g.oblk = 0;
    g.A = (const bf16_t*)(p.ws + WS_WUV); g.lda = 256; g.B = (const bf16_t*)((const char*)p.out + DO_ALLC); g.ldb = 256;
    g.TM = 8; g.TN = 328; g.K = 256; g.mode = 0; g.ob = (bf16_t*)(p.ws + WS_VT); g.ldo = NKEYP;
    run_gemm(p, g, smem);
    for (int j = VB; j < 72 * 8; j += NVB) gate_item(p, j >> 3, j & 7, smem);
  PH_END
  PH_BEGIN(4) phase_rowops_b(p); PH_END
  PH_BEGIN(5) phase_attn(p, smem, s_pair); PH_END
  PH_BEGIN(6) phase_rowops_c(p, smem); if ((PROBE_DUP >> 6) & 1) { xcd_barrier(xb); phase_rowops_c(p, smem); } PH_END
  PH_BEGIN(7)
    GemmArgs g; g.rss = (float*)(p.ws + WS_HSS); g.gain = p.norm_ffn; g.blk = 0; g.oblk = 0; g.A = (const bf16_t*)(p.ws + WS_BIG); g.lda = 2048; g.B = (const bf16_t*)(p.ws + WS_WOUT); g.ldb = 2048;
    g.TM = 32; g.TN = 8; g.K = 2048; g.mode = 2; g.ob = (bf16_t*)(p.ws + WS_A); g.ldo = 0; g.blk = 1;
    run_gemm_c(p, g, smem_all);
  PH_END
  PH_BEGIN(9)
    GemmArgs g; g.rss = (float*)(p.ws + WS_HSS); g.gain = nullptr; g.blk = 0; g.oblk = 0; g.A = (const bf16_t*)(p.ws + WS_A); g.lda = 2048; g.B = (const bf16_t*)(p.ws + WS_WUP); g.ldb = 2048;
    g.TM = 32; g.TN = 32; g.K = 2048; g.mode = 1; g.ob = (bf16_t*)(p.ws + WS_ACT); g.ldo = 8192; g.blk = 1; g.oblk = 1;
    run_gemm_c(p, g, smem_all);
  PH_END
  PH_BEGIN(10)
    GemmArgs g; g.rss = nullptr; g.gain = nullptr; g.blk = 0; g.oblk = 0; g.A = (const bf16_t*)(p.ws + WS_ACT); g.lda = 8192; g.B = (const bf16_t*)(p.ws + WS_WDN); g.ldb = 8192;
    g.TM = 32; g.TN = 8; g.K = 8192; g.mode = 3; g.ob = nullptr; g.ldo = 0; g.blk = 1;
    run_gemm_c(p, g, smem_all);
  PH_END
}

extern "C" void kernel_launch(void* const* d_in, const int* in_sizes, int n_in, void* d_out, int out_size, void* d_ws, size_t ws_size,
                              hipStream_t stream) {
  static int grid_blocks = 0;
  if (!grid_blocks) {
    int dev = 0, cus = 0, per_cu = 0;
    hipGetDevice(&dev);
    hipDeviceGetAttribute(&cus, hipDeviceAttributeMultiprocessorCount, dev);
    hipOccupancyMaxActiveBlocksPerMultiprocessor(&per_cu, hymba_megakernel, 512, 0);
    if (per_cu > 1) per_cu = 1;
    if (per_cu < 1) per_cu = 1;
    grid_blocks = cus * per_cu;
  }
  if (ws_size < WS_TOTAL) { fprintf(stderr, "workspace too small: %zu < %zu\n", ws_size, (size_t)WS_TOTAL); }
  Params p{};
  const float** f = (const float**)&p;
  for (int i = 0; i < 24; ++i) f[i] = (const float*)d_in[i];
  p.out = (float*)d_out;
  p.ws = (char*)d_ws;
  p.pad = 0;
  hipMemsetAsync((char*)d_ws + WS_CNT, 0, 256 + 16384 + 36864, stream);
#if MK_SINGLE_LAUNCH
  p.phase_lo = 0; p.phase_hi = 11; p.coop = 1;
  void* args[] = {&p};
  hipError_t e = hipLaunchCooperativeKernel((void*)hymba_megakernel, dim3(grid_blocks), dim3(512), args, 0, stream);
  if (e != hipSuccess) fprintf(stderr, "cooperative launch failed: %s (grid %d)\n", hipGetErrorString(e), grid_blocks);
#else
  for (int ph = 0; ph < 11; ++ph) {
    p.phase_lo = ph; p.phase_hi = ph + 1; p.coop = 0;
    hipLaunchKernelGGL(hymba_megakernel, dim3(grid_blocks), dim3(512), 0, stream, p);
  }
#endif
}
```

```cpp
#include <hip/hip_runtime.h>
#include <hip/hip_cooperative_groups.h>
#include <cstdio>
namespace cg = cooperative_groups;

#ifndef MK_SINGLE_LAUNCH
#define MK_SINGLE_LAUNCH 1
#endif

#define DI __device__ __forceinline__
typedef unsigned short bf16_t;
typedef short bf16x8 __attribute__((ext_vector_type(8)));
typedef short s16x4 __attribute__((ext_vector_type(4)));
typedef float f32x4 __attribute__((ext_vector_type(4)));
typedef float f32x16 __attribute__((ext_vector_type(16)));
typedef __bf16 bfv2 __attribute__((ext_vector_type(2)));
typedef float fv2 __attribute__((ext_vector_type(2)));
typedef unsigned u32x4 __attribute__((ext_vector_type(4)));
#define VTID ((int)(threadIdx.x & 255))
#define VHALF ((int)(threadIdx.x >> 8))
#define VB ((int)(blockIdx.x * 2 + (threadIdx.x >> 8)))
#define NVB ((int)(gridDim.x * 2))

constexpr int NTOK = 9216;
constexpr int NPT = 8192;
constexpr int NKEY = 41984;
constexpr int NKEYP = 42048;
constexpr int ZLD = 3072;
constexpr float EPS = 1e-6f;

constexpr size_t O_YS = 16777216, O_CKVP = 18874368, O_KPEP = 20971520, O_CKVS = 21495808, O_KPES = 21757952, O_VS = 21823488;
constexpr size_t DO_U = 0, DO_V = 18874368, DO_ALLC = 37748736, DO_ALLPE = 59244544;
constexpr size_t WS_WUQ = 0;
constexpr size_t WS_WUK = WS_WUQ + 1572864;
constexpr size_t WS_WUV = WS_WUK + 524288;
constexpr size_t WS_WOUT = WS_WUV + 524288;
constexpr size_t WS_WSPP = WS_WOUT + 8388608;
constexpr size_t WS_WSPS = WS_WSPP + 262144;
constexpr size_t WS_ROPE = WS_WSPS + 262144;
constexpr size_t WS_RSK = WS_ROPE + 524288;
constexpr size_t WS_CNT = WS_RSK + 1345536;
constexpr size_t WS_BAR = WS_CNT + 256;
constexpr size_t WS_HSS = WS_BAR + 16384;
constexpr size_t WS_A = WS_HSS + 36864;
constexpr size_t WS_QN = WS_A + 28311552;
constexpr size_t WS_BIG = WS_A + 37748736;
constexpr size_t WS_WIN = WS_BIG;
constexpr size_t WS_Z = WS_BIG + 12582912;
constexpr size_t WS_KN = WS_BIG;
constexpr size_t WS_VT = WS_BIG + 86114304;
constexpr size_t WS_ACT = WS_BIG;
constexpr size_t WS_WUP = WS_BIG + 172228608;
constexpr size_t WS_WDN = WS_WUP + 33554432;
constexpr size_t WS_TOTAL = WS_WDN + 33554432;

struct Params {
  const float *xp, *xs, *cache_c, *cache_pe, *norm_mix, *w_in, *q_lat_norm, *kv_lat_norm, *w_uq, *w_uk, *w_uv;
  const float *q_norm_nope, *q_norm_rope, *k_norm_nope, *k_norm_rope, *v_norm, *w_spatial, *b_spatial;
  const float *out_norm_attn, *out_norm_gmlp, *w_out, *norm_ffn, *w_up, *w_down;
  float* out;
  char* ws;
  int phase_lo, phase_hi, coop, pad;
};

DI unsigned pack2(float a, float b) { fv2 v = {a, b}; bfv2 r = __builtin_convertvector(v, bfv2); return __builtin_bit_cast(unsigned, r); }
DI float bflo(unsigned u) { return __uint_as_float(u << 16); }
DI float bfhi(unsigned u) { return __uint_as_float(u & 0xffff0000u); }
DI float wave_sum(float v) {
#pragma unroll
  for (int o = 32; o > 0; o >>= 1) v += __shfl_xor(v, o);
  return v;
}
DI float grp_sum(float v, int width) {
#pragma unroll
  for (int o = 1; o < 16; o <<= 1) if (o < width) v += __shfl_xor(v, o);
  return v;
}
DI float gelu_tanh(float x) {
  const float y = 0.7978845608028654f * (x + 0.044715f * x * x * x);
  const float e = __builtin_amdgcn_exp2f(y * 2.8853900817779268f);
  return x - x * __builtin_amdgcn_rcpf(1.0f + e);
}
DI void unpack8(uint4 d, float* f) {
  f[0] = bflo(d.x); f[1] = bfhi(d.x); f[2] = bflo(d.y); f[3] = bfhi(d.y);
  f[4] = bflo(d.z); f[5] = bfhi(d.z); f[6] = bflo(d.w); f[7] = bfhi(d.w);
}
DI uint4 pack8(const float* f) { return make_uint4(pack2(f[0], f[1]), pack2(f[2], f[3]), pack2(f[4], f[5]), pack2(f[6], f[7])); }


#define XB_TMO      128
#define XB_XCNT(j)  (256  + 64 * (j))
#define XB_XSUB(j)  (1280 + 64 * (j))
#define XB_XGEN(j)  (2304 + 64 * (j))
#define XB_TOP      3328
#define XB_TOPGEN   3392
#define XCD_BAR_WORDS 3456
#define XB_SPIN_CAP (1u << 18)
#define LAS __attribute__((address_space(3)))
DI unsigned xb_ld(unsigned* p) { return __hip_atomic_load(p, __ATOMIC_RELAXED, __HIP_MEMORY_SCOPE_AGENT); }
DI unsigned xb_add(unsigned* p, unsigned v) { return __hip_atomic_fetch_add(p, v, __ATOMIC_RELAXED, __HIP_MEMORY_SCOPE_AGENT); }
DI unsigned xb_xcc_id() { return (unsigned)__builtin_amdgcn_s_getreg((3 << 11) | 20) & 0xFu; }
#define XB_SPIN(cond, bar) do { unsigned _sp = 0; while (cond) { __builtin_amdgcn_s_sleep(1); \
    if ((++_sp & 255u) == 0u) { if (xb_ld(&(bar)[XB_TMO])) break; if (_sp > XB_SPIN_CAP) { atomicAdd(&(bar)[XB_TMO], 1u); break; } } } } while (0)
struct XcdBarrier { unsigned* bar; unsigned x; volatile LAS unsigned* st; };
DI XcdBarrier xcd_barrier_post(unsigned* bar, volatile LAS unsigned* st) {
  XcdBarrier b; b.bar = bar; b.x = xb_xcc_id(); b.st = st;
  if (threadIdx.x == 0) (void)xb_add(&bar[XB_XCNT(b.x)], 1u);
  return b;
}
DI void xcd_barrier_complete(unsigned* bar, unsigned x, unsigned& nloc, unsigned& nx) {
  const unsigned G = gridDim.x * gridDim.y * gridDim.z;
  unsigned sum, cnt, mine, sp = 0u;
  for (;;) {
    sum = 0u; cnt = 0u; mine = 0u;
#pragma unroll
    for (unsigned j = 0; j < 16; ++j) { const unsigned c = xb_ld(&bar[XB_XCNT(j)]); sum += c; cnt += (c > 0u) ? 1u : 0u; mine = (j == x) ? c : mine; }
    if (sum == G) break;
    __builtin_amdgcn_s_sleep(1);
    if ((++sp & 255u) == 0u) { if (xb_ld(&bar[XB_TMO])) break; if (sp > XB_SPIN_CAP) { atomicAdd(&bar[XB_TMO], 1u); break; } }
  }
  nloc = mine > 0u ? mine : 1u; nx = cnt > 0u ? cnt : 1u;
}
DI void xcd_barrier(const XcdBarrier& b) {
  asm volatile("s_waitcnt vmcnt(0)" ::: "memory");
  __syncthreads();
  if (threadIdx.x == 0) {
    unsigned* bar = b.bar;
    __builtin_amdgcn_s_waitcnt(0);
    unsigned nloc = b.st[0], nx = b.st[1];
    if (nloc == 0u) { xcd_barrier_complete(bar, b.x, nloc, nx); b.st[0] = nloc; b.st[1] = nx; }
    const unsigned old = xb_add(&bar[XB_XSUB(b.x)], 1u);
    const unsigned gen = old / nloc;
    if (old + 1u == (gen + 1u) * nloc) {
      __builtin_amdgcn_fence(__ATOMIC_RELEASE, "agent");
      asm volatile("s_waitcnt vmcnt(0)" ::: "memory");
      const unsigned og = xb_add(&bar[XB_TOP], 1u);
      const unsigned tg = og / nx;
      if (og + 1u == (tg + 1u) * nx) xb_add(&bar[XB_TOPGEN], 1u);
      else XB_SPIN(xb_ld(&bar[XB_TOPGEN]) == tg, bar);
      __builtin_amdgcn_fence(__ATOMIC_ACQUIRE, "agent");
      xb_add(&bar[XB_XGEN(b.x)], 1u);
      asm volatile("s_waitcnt vmcnt(0)" ::: "memory");
    } else {
      XB_SPIN(xb_ld(&bar[XB_XGEN(b.x)]) == gen, bar);
      __builtin_amdgcn_fence(__ATOMIC_ACQUIRE, "agent");
      asm volatile("s_waitcnt vmcnt(0)" ::: "memory");
    }
  }
  __syncthreads();
}

DI void glds16(const void* gsrc, unsigned lds_dst) {
  unsigned keep;
  asm volatile("s_mov_b32 %0, m0\n\ts_mov_b32 m0, %2\n\ts_nop 0\n\tglobal_load_lds_dwordx4 %1, off\n\ts_mov_b32 m0, %0"
               : "=&s"(keep) : "v"(gsrc), "s"(lds_dst) : "memory");
}

DI void glds16s(const void* sbase, unsigned voff, unsigned lds_dst) {
  unsigned keep;
  lds_dst = __builtin_amdgcn_readfirstlane(lds_dst);
  { const unsigned long long b_ = (unsigned long long)sbase;
    const unsigned lo_ = __builtin_amdgcn_readfirstlane((unsigned)b_), hi_ = __builtin_amdgcn_readfirstlane((unsigned)(b_ >> 32));
    sbase = (const void*)(((unsigned long long)hi_ << 32) | lo_); }
  asm volatile("s_mov_b32 %0, m0\n\ts_mov_b32 m0, %3\n\ts_nop 0\n\tglobal_load_lds_dwordx4 %1, %2\n\ts_mov_b32 m0, %0"
               : "=&s"(keep) : "v"(voff), "s"(sbase), "s"(lds_dst) : "memory");
}

DI int lds_byte(int r, int c) {
  const int st = (r >> 4) * 2 + (c >> 5), rr = r & 15, cc = c & 31, ob = rr * 64 + cc * 2;
  return st * 1024 + (ob ^ (((ob >> 9) & 1) << 5));
}

DI int slot_index(int it) {
  const int nvb = NVB, nbr = gridDim.x, b = blockIdx.x;
  if ((nbr & 7) == 0) return it * nvb + (b & 7) * (nvb >> 3) + (b >> 3) * 2 + VHALF;
  return it * nvb + VB;
}

DI void transpose_tile(const float* __restrict__ src, int ldsrc, bf16_t* __restrict__ dst, int lddst, int k0, int n0, float* lds) {
  const int tid = VTID, kr = tid >> 4, nc = tid & 15;
#pragma unroll
  for (int i = 0; i < 4; ++i) {
    const float4 v = *(const float4*)(src + (size_t)(k0 + kr + 16 * i) * ldsrc + n0 + 4 * nc);
    float* d = lds + (kr + 16 * i) * 65 + 4 * nc;
    d[0] = v.x; d[1] = v.y; d[2] = v.z; d[3] = v.w;
  }
  __syncthreads();
  const int n = tid >> 2, kc = tid & 3;
  unsigned pk[8];
#pragma unroll
  for (int j = 0; j < 8; ++j) pk[j] = pack2(lds[(kc * 16 + 2 * j) * 65 + n], lds[(kc * 16 + 2 * j + 1) * 65 + n]);
  uint4* o = (uint4*)(dst + (size_t)(n0 + n) * lddst + k0 + kc * 16);
  o[0] = make_uint4(pk[0], pk[1], pk[2], pk[3]);
  o[1] = make_uint4(pk[4], pk[5], pk[6], pk[7]);
  __syncthreads();
}

DI void transpose_tile_blk(const float* __restrict__ src, int ldsrc, bf16_t* __restrict__ dst, int nk, int k0, int n0, float* lds) {
  const int tid = VTID, kr = tid >> 4, nc = tid & 15;
#pragma unroll
  for (int i = 0; i < 4; ++i) {
    const float4 v = *(const float4*)(src + (size_t)(k0 + kr + 16 * i) * ldsrc + n0 + 4 * nc);
    float* d = lds + (kr + 16 * i) * 65 + 4 * nc;
    d[0] = v.x; d[1] = v.y; d[2] = v.z; d[3] = v.w;
  }
  __syncthreads();
  const int n = tid >> 2, kc = tid & 3;
  unsigned pk[8];
#pragma unroll
  for (int j = 0; j < 8; ++j) pk[j] = pack2(lds[(kc * 16 + 2 * j) * 65 + n], lds[(kc * 16 + 2 * j + 1) * 65 + n]);
  const int nn = n0 + n, kk = k0 + kc * 16;
  uint4* o = (uint4*)(dst + ((size_t)((nn >> 8) * nk + (kk >> 5)) * 256 + (nn & 255)) * 32 + (kk & 31));
  o[0] = make_uint4(pk[0], pk[1], pk[2], pk[3]);
  o[1] = make_uint4(pk[4], pk[5], pk[6], pk[7]);
  __syncthreads();
}

DI void rms_row2048_blk(const float* __restrict__ src, const float* __restrict__ gain, bf16_t* __restrict__ base, int r, int lane) {
  float4 v[8];
  float ss = 0.f;
#pragma unroll
  for (int i = 0; i < 8; ++i) { v[i] = *(const float4*)(src + i * 256 + lane * 4); ss += v[i].x * v[i].x + v[i].y * v[i].y + v[i].z * v[i].z + v[i].w * v[i].w; }
  ss = wave_sum(ss);
  const float rs = rsqrtf(ss * (1.0f / 2048.0f) + EPS);
  const int tmr = r / 288, rr = r - tmr * 288;
#pragma unroll
  for (int i = 0; i < 8; ++i) {
    const float4 g = *(const float4*)(gain + i * 256 + lane * 4);
    uint2 o; o.x = pack2(v[i].x * rs * g.x, v[i].y * rs * g.y); o.y = pack2(v[i].z * rs * g.z, v[i].w * rs * g.w);
    const int c = i * 256 + lane * 4;
    *(uint2*)(base + ((size_t)(tmr * 64 + (c >> 5)) * 288 + rr) * 32 + (c & 31)) = o;
  }
}

DI void rms_row2048(const float* __restrict__ src, const float* __restrict__ gain, bf16_t* __restrict__ dst, int lane) {
  float4 v[8];
  float ss = 0.f;
#pragma unroll
  for (int i = 0; i < 8; ++i) { v[i] = *(const float4*)(src + i * 256 + lane * 4); ss += v[i].x * v[i].x + v[i].y * v[i].y + v[i].z * v[i].z + v[i].w * v[i].w; }
  ss = wave_sum(ss);
  const float rs = rsqrtf(ss * (1.0f / 2048.0f) + EPS);
#pragma unroll
  for (int i = 0; i < 8; ++i) {
    const float4 g = *(const float4*)(gain + i * 256 + lane * 4);
    uint2 o; o.x = pack2(v[i].x * rs * g.x, v[i].y * rs * g.y); o.y = pack2(v[i].z * rs * g.z, v[i].w * rs * g.w);
    *(uint2*)(dst + i * 256 + lane * 4) = o;
  }
}

DI void phase_prep(const Params& p, char* smem, const int part, const int b, const int nb) {
  const int tid = VTID, lane = tid & 63, wid = tid >> 6;
  char* ws = p.ws;
  {
    const int n_in = 32 * 45, n_uq = 8 * 24, n_uk = 4 * 16, n_uv = 4 * 16, n_out = 0;
    const int total = n_in + n_uq + n_uk + n_uv + n_out;
    for (int j = (part == 0 ? b : n_in + b); j < (part == 0 ? n_in : total); j += nb) {
      int t = j;
      if (t < n_in) { transpose_tile_blk(p.w_in, 2880, (bf16_t*)(ws + WS_WIN), 64, (t / 45) * 64, (t % 45) * 64, (float*)smem); continue; }
      t -= n_in;
      if (t < n_uq) { transpose_tile(p.w_uq, 1536, (bf16_t*)(ws + WS_WUQ), 512, (t / 24) * 64, (t % 24) * 64, (float*)smem); continue; }
      t -= n_uq;
      if (t < n_uk) { transpose_tile(p.w_uk, 1024, (bf16_t*)(ws + WS_WUK), 256, (t / 16) * 64, (t % 16) * 64, (float*)smem); continue; }
      t -= n_uk;
      if (t < n_uv) { transpose_tile(p.w_uv, 1024, (bf16_t*)(ws + WS_WUV), 256, (t / 16) * 64, (t % 16) * 64, (float*)smem); continue; }
      t -= n_uv;
      transpose_tile(p.w_out, 2048, (bf16_t*)(ws + WS_WOUT), 2048, (t / 32) * 64, (t % 32) * 64, (float*)smem);
    }
  }
  const int gtid = b * 256 + tid, gthreads = nb * 256;
  if (part == 0) {
  for (int i = gtid; i < 64 * 768; i += gthreads) {
    const int ks = i / 768, off = i - ks * 768;
    ((uint4*)(ws + WS_WIN + ((size_t)((11 * 64 + ks) * 256 + 64) * 32) * 2))[off] = make_uint4(0, 0, 0, 0);
  }
  for (int i = gtid; i < NKEYP * 8 / 4; i += gthreads) ((float4*)(ws + WS_RSK))[i] = make_float4(0.f, 0.f, 0.f, 0.f);
  for (int i = gtid; i < 8 * 128 * 128; i += gthreads) {
    const int g = i >> 14, t = (i >> 7) & 127, s = i & 127;
    const float wp = (s <= t) ? p.w_spatial[i] : 0.f;
    const float wsv = ((t >> 5) == (s >> 5) && (s & 31) <= (t & 31)) ? p.w_spatial[(g << 14) + ((t & 31) << 7) + (s & 31)] : 0.f;
    ((bf16_t*)(ws + WS_WSPP))[i] = (bf16_t)(pack2(wp, 0.f) & 0xffffu);
    ((bf16_t*)(ws + WS_WSPS))[i] = (bf16_t)(pack2(wsv, 0.f) & 0xffffu);
  }
  for (int i = gtid; i < 2048 * 32; i += gthreads) {
    const int pos = i >> 5, k = i & 31;
    const float inv = (float)exp2(-(double)k * (13.287712379549449 / 32.0));
    const float ang = (float)pos * inv;
    const double rev = (double)ang * 0.15915494309189535;
    const float fr = (float)(rev - rint(rev));
    float2 cs; cs.x = __builtin_amdgcn_cosf(fr); cs.y = __builtin_amdgcn_sinf(fr);
    ((float2*)(ws + WS_ROPE))[i] = cs;
  }
  }
  if (part == 1) {
    bf16_t* allc = (bf16_t*)((char*)p.out + DO_ALLC);
    for (int i = gtid; i < 32 * 1024 * 256 / 8; i += gthreads) {
      const int e = i * 8, c = e & 255, row = e >> 8, bb = row >> 10, pp = row & 1023;
      const float4 a = *(const float4*)(p.cache_c + e), d = *(const float4*)(p.cache_c + e + 4);
      *(uint4*)(allc + (size_t)(NPT + bb * 1056 + pp) * 256 + c) = make_uint4(pack2(a.x, a.y), pack2(a.z, a.w), pack2(d.x, d.y), pack2(d.z, d.w));
    }
    bf16_t* allpe = (bf16_t*)((char*)p.out + DO_ALLPE);
    for (int i = gtid; i < 32 * 1024 * 64 / 8; i += gthreads) {
      const int e = i * 8, c = e & 63, row = e >> 6, bb = row >> 10, pp = row & 1023;
      const float4 a = *(const float4*)(p.cache_pe + e), d = *(const float4*)(p.cache_pe + e + 4);
      *(uint4*)(allpe + (size_t)(NPT + bb * 1056 + pp) * 64 + c) = make_uint4(pack2(a.x, a.y), pack2(a.z, a.w), pack2(d.x, d.y), pack2(d.z, d.w));
    }
  }
  if (part == 0) {
    bf16_t* xn = (bf16_t*)(ws + WS_A);
    for (int r = b * 4 + wid; r < NTOK; r += nb * 4) {
      const float* src = r < NPT ? p.xp + (size_t)r * 2048 : p.xs + (size_t)(r - NPT) * 2048;
      rms_row2048_blk(src, p.norm_mix, xn, r, lane);
    }
  }
}

struct GemmArgs {
  const bf16_t* A; int lda;
  const bf16_t* B; int ldb;
  int TM, TN, K;
  int mode;
  bf16_t* ob; int ldo;
  int blk;
  int oblk;
  const float* gain;
  float* rss;
};

DI void mma_kstep(const char* sa, const char* sb, f32x4 (&acc)[4][4], int wr, int wc, int fr, int fq) {
#pragma unroll
  for (int k = 0; k < 2; ++k) {
    bf16x8 a[4], bq[4];
#pragma unroll
    for (int m = 0; m < 4; ++m) a[m] = *(const bf16x8*)(sa + lds_byte(wr * 64 + m * 16 + fr, k * 32 + fq * 8));
#pragma unroll
    for (int n = 0; n < 4; ++n) bq[n] = *(const bf16x8*)(sb + lds_byte(wc * 64 + n * 16 + fr, k * 32 + fq * 8));
#pragma unroll
    for (int m = 0; m < 4; ++m)
#pragma unroll
      for (int n = 0; n < 4; ++n) acc[m][n] = __builtin_amdgcn_mfma_f32_16x16x32_bf16(bq[n], a[m], acc[m][n], 0, 0, 0);
  }
}

DI void gemm_tile(const Params& p, const GemmArgs& g, int tm, int tn, char* smem, int kt0 = 0, int kt1 = -1) {
  const int tid = VTID, lane = tid & 63, wid = tid >> 6, wr = wid >> 1, wc = wid & 1, fr = lane & 15, fq = lane >> 4;
  int sR, sC;
  {
    const int bb = tid * 16, st = bb >> 10, sb = bb & 1023, swz = sb ^ (((sb >> 9) & 1) << 5);
    sR = (st >> 1) * 16 + (swz >> 6); sC = (st & 1) * 32 + ((swz & 63) >> 1);
  }
  const bf16_t* Ag = g.A + (size_t)(tm * 128 + sR) * g.lda + sC;
  const bf16_t* Bg = g.B + (size_t)(tn * 128 + sR) * g.ldb + sC;
  const size_t astep = (size_t)32 * g.lda, bstep = (size_t)32 * g.ldb;
  f32x4 acc[4][4];
#pragma unroll
  for (int m = 0; m < 4; ++m)
#pragma unroll
    for (int n = 0; n < 4; ++n) acc[m][n] = (f32x4){0.f, 0.f, 0.f, 0.f};
  const int nk = kt1 < 0 ? (g.K >> 6) : kt1;
  const bool partial = (kt0 != 0) || (nk != (g.K >> 6));
  const unsigned lds_wave = __builtin_amdgcn_readfirstlane((unsigned)(size_t)smem + wid * 1024);
#define GEMM_STAGE(kt, buf) do { \
    const unsigned d_ = lds_wave + (buf) * 32768; \
    const bf16_t* a_ = Ag + (kt) * 64; const bf16_t* b_ = Bg + (kt) * 64; \
    _Pragma("unroll") for (int i_ = 0; i_ < 4; ++i_) { \
      glds16(a_ + i_ * astep, d_ + i_ * 4096); \
      glds16(b_ + i_ * bstep, d_ + 16384 + i_ * 4096); } } while (0)
  GEMM_STAGE(kt0, kt0 & 1);
  for (int kt = kt0; kt < nk; ++kt) {
    const int buf = kt & 1;
    asm volatile("s_waitcnt vmcnt(0)" ::: "memory");
    __syncthreads();
    if (kt + 1 < nk) GEMM_STAGE(kt + 1, buf ^ 1);
    const char* sa = smem + buf * 32768; const char* sb = sa + 16384;
    bf16x8 af[2][4], bfr[2][4];
#pragma unroll
    for (int k = 0; k < 2; ++k) {
#pragma unroll
      for (int m = 0; m < 4; ++m) af[k][m] = *(const bf16x8*)(sa + lds_byte(wr * 64 + m * 16 + fr, k * 32 + fq * 8));
#pragma unroll
      for (int n = 0; n < 4; ++n) bfr[k][n] = *(const bf16x8*)(sb + lds_byte(wc * 64 + n * 16 + fr, k * 32 + fq * 8));
    }
#pragma unroll
    for (int k = 0; k < 2; ++k)
#pragma unroll
      for (int m = 0; m < 4; ++m)
#pragma unroll
        for (int n = 0; n < 4; ++n) acc[m][n] = __builtin_amdgcn_mfma_f32_16x16x32_bf16(bfr[k][n], af[k][m], acc[m][n], 0, 0, 0);
  }
  __syncthreads();
  const int row0 = tm * 128 + wr * 64 + fr, col0 = tn * 128 + wc * 64 + fq * 4;
  if (g.mode <= 1) {
    if (g.rss) {
#pragma unroll
      for (int m = 0; m < 4; ++m) {
        float ss = 0.f;
#pragma unroll
        for (int n = 0; n < 4; ++n)
#pragma unroll
          for (int j = 0; j < 4; ++j) ss += acc[m][n][j] * acc[m][n][j];
        ss += __shfl_xor(ss, 16); ss += __shfl_xor(ss, 32);
        if (fq == 0) unsafeAtomicAdd(g.rss + (size_t)(row0 + m * 16) * 8 + tn, ss);
      }
    }
    const int odd = fq & 1;
    const int cpair = odd ? 16 + (fq - 1) * 4 : fq * 4;
#pragma unroll
    for (int m = 0; m < 4; ++m) {
      const int row = row0 + m * 16;
      uint2 o[4];
#pragma unroll
      for (int n = 0; n < 4; ++n) {
        f32x4 v = acc[m][n];
        if (g.mode == 1) {
#pragma unroll
          for (int j = 0; j < 4; ++j) { const float r = fmaxf(v[j], 0.f); v[j] = r * r; }
        }
        o[n].x = pack2(v[0], v[1]); o[n].y = pack2(v[2], v[3]);
      }
      bf16_t* rowp = g.oblk == 2 ? g.ob + ((size_t)tn * NKEYP + row) * 128 + wc * 64 : g.ob + (size_t)row * g.ldo + tn * 128 + wc * 64;
#pragma unroll
      for (int j = 0; j < 2; ++j) {
        const uint2 keep = odd ? o[2 * j + 1] : o[2 * j];
        const uint2 send = odd ? o[2 * j] : o[2 * j + 1];
        uint2 recv; recv.x = __shfl_xor(send.x, 16); recv.y = __shfl_xor(send.y, 16);
        const uint4 wv = odd ? make_uint4(recv.x, recv.y, keep.x, keep.y) : make_uint4(keep.x, keep.y, recv.x, recv.y);
        *(uint4*)(rowp + j * 32 + cpair) = wv;
      }
    }
  } else if (g.mode == 2) {
#pragma unroll
    for (int m = 0; m < 4; ++m) {
      const int row = row0 + m * 16;
      const float* xr = (row < NPT ? p.xp + (size_t)row * 2048 : p.xs + (size_t)(row - NPT) * 2048) + col0;
      float* hr = p.out + (size_t)row * 2048 + col0;
#pragma unroll
      for (int n = 0; n < 4; ++n) {
        const float4 x = *(const float4*)(xr + n * 16);
        float4 o; o.x = x.x + acc[m][n][0]; o.y = x.y + acc[m][n][1]; o.z = x.z + acc[m][n][2]; o.w = x.w + acc[m][n][3];
        *(float4*)(hr + n * 16) = o;
      }
    }
  } else {
#pragma unroll
    for (int m = 0; m < 4; ++m) {
      float* hr = p.out + (size_t)(row0 + m * 16) * 2048 + col0;
#pragma unroll
      for (int n = 0; n < 4; ++n) {
        if (partial) {
          float* hp = hr + n * 16;
          unsafeAtomicAdd(hp, acc[m][n][0]); unsafeAtomicAdd(hp + 1, acc[m][n][1]); unsafeAtomicAdd(hp + 2, acc[m][n][2]); unsafeAtomicAdd(hp + 3, acc[m][n][3]);
        } else {
          float4 x = *(const float4*)(hr + n * 16);
          x.x += acc[m][n][0]; x.y += acc[m][n][1]; x.z += acc[m][n][2]; x.w += acc[m][n][3];
          *(float4*)(hr + n * 16) = x;
        }
      }
    }
  }
}


DI void gemm_tile_b(const Params& p, const GemmArgs& g, int tm, int tn, char* smem) {
  tm = __builtin_amdgcn_readfirstlane(tm); tn = __builtin_amdgcn_readfirstlane(tn);
  const int tid = VTID, lane = tid & 63, wid = tid >> 6, fr = lane & 15, fq = lane >> 4;
  int sR, sC;
  { const int sb = lane * 16, swz = sb ^ (((sb >> 9) & 1) << 5); sR = swz >> 6; sC = (swz & 63) >> 1; }
  const bf16_t* Ag = g.A + (size_t)(tm * 144) * g.lda;
  const bf16_t* Bg = g.B + (size_t)(tn * 256) * g.ldb;
  const unsigned voff = (unsigned)(sR * g.lda + sC) * 2u;
  const size_t a16 = (size_t)16 * g.lda, b16 = (size_t)16 * g.ldb;
  const int fo = (fr * 64 + fq * 16) ^ ((((fr * 64 + fq * 16) >> 9) & 1) << 5);
  const unsigned lds0 = __builtin_amdgcn_readfirstlane((unsigned)(size_t)smem);
  const int widu = __builtin_amdgcn_readfirstlane(wid);
  f32x4 acc[9][4];
#pragma unroll
  for (int m = 0; m < 9; ++m)
#pragma unroll
    for (int n = 0; n < 4; ++n) acc[m][n] = (f32x4){0.f, 0.f, 0.f, 0.f};
  const int nk = g.K >> 5;
#define GB_PIECE(kt, buf, i_) do { \
    int q_ = widu + 4 * (i_); if (q_ >= 25) q_ -= 4; \
    { \
      const unsigned d_ = lds0 + (buf) * 25600 + q_ * 1024; \
      if (q_ < 9) glds16s(Ag + (size_t)q_ * a16 + (kt) * 32, voff, d_); \
      else glds16s(Bg + (size_t)(q_ - 9) * b16 + (kt) * 32, voff, d_); } } while (0)
#pragma unroll
  for (int i = 0; i < 7; ++i) GB_PIECE(0, 0, i);
#pragma unroll
  for (int i = 0; i < 7; ++i) GB_PIECE(1, 1, i);
  int buf = 0, nbuf = 2;
  const int half = __builtin_amdgcn_readfirstlane(VHALF);
  if (half == 1) __builtin_amdgcn_s_barrier();
#pragma nounroll
  for (int kt = 0; kt < nk; ++kt) {
    if (kt + 1 < nk) asm volatile("s_waitcnt vmcnt(7)" ::: "memory");
    else asm volatile("s_waitcnt vmcnt(0)" ::: "memory");
    __builtin_amdgcn_s_barrier();
    if (kt + 2 < nk) {
#pragma unroll
      for (int i = 0; i < 7; ++i) GB_PIECE(kt + 2, nbuf, i);
    }
    const unsigned sa_addr = (unsigned)(size_t)smem + buf * 25600 + fo;
    const unsigned sb_addr = sa_addr + 9216 + wid * 4096;
    bf16x8 af[9], bfr[4];
    asm volatile(
        "ds_read_b128 %0, %14\n\t"
        "ds_read_b128 %1, %14 offset:1024\n\t"
        "ds_read_b128 %2, %14 offset:2048\n\t"
        "ds_read_b128 %3, %14 offset:3072\n\t"
        "ds_read_b128 %4, %13\n\t"
        "ds_read_b128 %5, %13 offset:1024\n\t"
        "ds_read_b128 %6, %13 offset:2048\n\t"
        "ds_read_b128 %7, %13 offset:3072\n\t"
        "ds_read_b128 %8, %13 offset:4096\n\t"
        "ds_read_b128 %9, %13 offset:5120\n\t"
        "ds_read_b128 %10, %13 offset:6144\n\t"
        "ds_read_b128 %11, %13 offset:7168\n\t"
        "ds_read_b128 %12, %13 offset:8192"
        : "=&v"(bfr[0]), "=&v"(bfr[1]), "=&v"(bfr[2]), "=&v"(bfr[3]), "=&v"(af[0]), "=&v"(af[1]), "=&v"(af[2]), "=&v"(af[3]), "=&v"(af[4]),
          "=&v"(af[5]), "=&v"(af[6]), "=&v"(af[7]), "=&v"(af[8])
        : "v"(sa_addr), "v"(sb_addr) : "memory");
    __builtin_amdgcn_s_barrier();
    __builtin_amdgcn_s_setprio(1);
#define GB_WAIT(n_, v_) asm volatile("s_waitcnt lgkmcnt(" #n_ ")" : "+v"(v_))
#define GB_ROW(m_) _Pragma("unroll") for (int n = 0; n < 4; ++n) acc[m_][n] = __builtin_amdgcn_mfma_f32_16x16x32_bf16(bfr[n], af[m_], acc[m_][n], 0, 0, 0)
    GB_WAIT(8, af[0]); GB_ROW(0);
    GB_WAIT(7, af[1]); GB_ROW(1);
    GB_WAIT(6, af[2]); GB_ROW(2);
    GB_WAIT(5, af[3]); GB_ROW(3);
    GB_WAIT(4, af[4]); GB_ROW(4);
    GB_WAIT(3, af[5]); GB_ROW(5);
    GB_WAIT(2, af[6]); GB_ROW(6);
    GB_WAIT(1, af[7]); GB_ROW(7);
    GB_WAIT(0, af[8]); GB_ROW(8);
    __builtin_amdgcn_s_setprio(0);
    buf = buf == 2 ? 0 : buf + 1;
    nbuf = nbuf == 2 ? 0 : nbuf + 1;
  }
  if (half == 0) __builtin_amdgcn_s_barrier();
  __syncthreads();
  const int row0 = tm * 144 + fr, col0 = tn * 256 + wid * 64 + fq * 4;
  if (g.mode == 1) {
#pragma unroll
    for (int m = 0; m < 9; ++m) {
      bf16_t* rp = g.ob + (size_t)(row0 + m * 16) * g.ldo + col0;
#pragma unroll
      for (int n = 0; n < 4; ++n) {
        f32x4 v = acc[m][n];
#pragma unroll
        for (int j = 0; j < 4; ++j) { const float r = fmaxf(v[j], 0.f); v[j] = r * r; }
        uint2 o; o.x = pack2(v[0], v[1]); o.y = pack2(v[2], v[3]);
        *(uint2*)(rp + n * 16) = o;
      }
    }
  } else if (g.mode == 2) {
#pragma unroll
    for (int m = 0; m < 9; ++m) {
      const int row = row0 + m * 16;
      const float* xr = (row < NPT ? p.xp + (size_t)row * 2048 : p.xs + (size_t)(row - NPT) * 2048) + col0;
      float* hr = p.out + (size_t)row * 2048 + col0;
#pragma unroll
      for (int n = 0; n < 4; ++n) {
        const float4 x = *(const float4*)(xr + n * 16);
        float4 o; o.x = x.x + acc[m][n][0]; o.y = x.y + acc[m][n][1]; o.z = x.z + acc[m][n][2]; o.w = x.w + acc[m][n][3];
        *(float4*)(hr + n * 16) = o;
      }
      asm volatile("" ::: "memory");
    }
  } else {
#pragma unroll
    for (int m = 0; m < 9; ++m) {
      float* hr = p.out + (size_t)(row0 + m * 16) * 2048 + col0;
#pragma unroll
      for (int n = 0; n < 4; ++n) {
        float4 x = *(const float4*)(hr + n * 16);
        x.x += acc[m][n][0]; x.y += acc[m][n][1]; x.z += acc[m][n][2]; x.w += acc[m][n][3];
        *(float4*)(hr + n * 16) = x;
      }
      asm volatile("" ::: "memory");
    }
  }
}


DI void gemm_tile_c(const Params& p, const GemmArgs& g, int tm, int tn, char* smem) {
  const int lane = threadIdx.x & 63, fr = lane & 15, fq = lane >> 4;
  const int w = __builtin_amdgcn_readfirstlane((int)(threadIdx.x >> 6)), half = w >> 2, wn = w & 3;
  int sR, sC;
  { const int sb = lane * 16, swz = sb ^ (((sb >> 9) & 1) << 5); sR = swz >> 6; sC = (swz & 63) >> 1; }
  const int nkk = g.K >> 5;
  const bf16_t* Ag = g.blk ? g.A + (size_t)tm * nkk * 9216 : g.A + (size_t)(tm * 288) * g.lda;
  const bf16_t* Bg = g.blk ? g.B + (size_t)tn * nkk * 8192 : g.B + (size_t)(tn * 256) * g.ldb;
  const unsigned voff = g.blk ? (unsigned)(sR * 32 + sC) * 2u : (unsigned)(sR * g.lda + sC) * 2u;
  const size_t a16 = g.blk ? (size_t)512 : (size_t)16 * g.lda, b16 = g.blk ? (size_t)512 : (size_t)16 * g.ldb;
  const size_t kA = g.blk ? (size_t)9216 : (size_t)32, kB = g.blk ? (size_t)8192 : (size_t)32;
  const int fo = (fr * 64 + fq * 16) ^ ((((fr * 64 + fq * 16) >> 9) & 1) << 5);
  const unsigned lds0 = __builtin_amdgcn_readfirstlane((unsigned)(size_t)smem);
  f32x4 acc[9][4];
#pragma unroll
  for (int m = 0; m < 9; ++m)
#pragma unroll
    for (int n = 0; n < 4; ++n) acc[m][n] = (f32x4){0.f, 0.f, 0.f, 0.f};
  const int nk = g.K >> 5;
#define GC_PIECE(kt, i_) do { const unsigned d_ = lds0 + ((kt) & 3) * 34816; \
    if ((i_) == 0) glds16s(Ag + (size_t)w * a16 + (size_t)(kt) * kA, voff, d_ + w * 1024); \
    else if ((i_) == 1) glds16s(Ag + (size_t)(w + 8) * a16 + (size_t)(kt) * kA, voff, d_ + (w + 8) * 1024); \
    else if ((i_) == 2) glds16s(Bg + (size_t)w * b16 + (size_t)(kt) * kB, voff, d_ + 18432 + w * 1024); \
    else if ((i_) == 3) glds16s(Bg + (size_t)(w + 8) * b16 + (size_t)(kt) * kB, voff, d_ + 18432 + (w + 8) * 1024); \
    else if (w < 2) glds16s(Ag + (size_t)(w + 16) * a16 + (size_t)(kt) * kA, voff, d_ + (w + 16) * 1024); } while (0)
#pragma unroll
  for (int st = 0; st < 3; ++st)
    if (st < nk) {
#pragma unroll
      for (int i = 0; i < 5; ++i) GC_PIECE(st, i);
    }
  if (w < 2) asm volatile("s_waitcnt vmcnt(10)" ::: "memory"); else asm volatile("s_waitcnt vmcnt(8)" ::: "memory");
  __builtin_amdgcn_s_barrier();
  if (half == 1) __builtin_amdgcn_s_barrier();
#pragma nounroll
  for (int kt = 0; kt < nk; ++kt) {
    __builtin_amdgcn_s_barrier();
    if (kt + 3 < nk) { GC_PIECE(kt + 3, 0); GC_PIECE(kt + 3, 1); GC_PIECE(kt + 3, 2); GC_PIECE(kt + 3, 3); GC_PIECE(kt + 3, 4); }
    const unsigned sa_addr = lds0 + (kt & 3) * 34816 + half * 9216 + fo;
    const unsigned sb_addr = lds0 + (kt & 3) * 34816 + 18432 + wn * 4096 + fo;
    bf16x8 af[9], bfr[4];
    asm volatile(
        "ds_read_b128 %0, %14\n\t"
        "ds_read_b128 %1, %14 offset:1024\n\t"
        "ds_read_b128 %2, %14 offset:2048\n\t"
        "ds_read_b128 %3, %14 offset:3072\n\t"
        "ds_read_b128 %4, %13\n\t"
        "ds_read_b128 %5, %13 offset:1024\n\t"
        "ds_read_b128 %6, %13 offset:2048\n\t"
        "ds_read_b128 %7, %13 offset:3072\n\t"
        "ds_read_b128 %8, %13 offset:4096\n\t"
        "ds_read_b128 %9, %13 offset:5120\n\t"
        "ds_read_b128 %10, %13 offset:6144\n\t"
        "ds_read_b128 %11, %13 offset:7168\n\t"
        "ds_read_b128 %12, %13 offset:8192"
        : "=&v"(bfr[0]), "=&v"(bfr[1]), "=&v"(bfr[2]), "=&v"(bfr[3]), "=&v"(af[0]), "=&v"(af[1]), "=&v"(af[2]), "=&v"(af[3]), "=&v"(af[4]),
          "=&v"(af[5]), "=&v"(af[6]), "=&v"(af[7]), "=&v"(af[8])
        : "v"(sa_addr), "v"(sb_addr) : "memory");
    if (kt + 3 < nk) { if (w < 2) asm volatile("s_waitcnt vmcnt(10)" ::: "memory"); else asm volatile("s_waitcnt vmcnt(8)" ::: "memory"); }
    else if (kt + 2 < nk) { if (w < 2) asm volatile("s_waitcnt vmcnt(5)" ::: "memory"); else asm volatile("s_waitcnt vmcnt(4)" ::: "memory"); }
    else asm volatile("s_waitcnt vmcnt(0)" ::: "memory");
    asm volatile("s_waitcnt lgkmcnt(0)"
                 : "+v"(bfr[0]), "+v"(bfr[1]), "+v"(bfr[2]), "+v"(bfr[3]), "+v"(af[0]), "+v"(af[1]), "+v"(af[2]), "+v"(af[3]), "+v"(af[4]),
                   "+v"(af[5]), "+v"(af[6]), "+v"(af[7]), "+v"(af[8]) :: "memory");
    __builtin_amdgcn_s_barrier();
#define GC_WAIT(n_, v_) asm volatile("s_waitcnt lgkmcnt(" #n_ ")" : "+v"(v_))
#define GC_ROW(m_) _Pragma("unroll") for (int n = 0; n < 4; ++n) acc[m_][n] = __builtin_amdgcn_mfma_f32_16x16x32_bf16(bfr[n], af[m_], acc[m_][n], 0, 0, 0)
    GC_ROW(0); GC_ROW(1); GC_ROW(2); GC_ROW(3); GC_ROW(4); GC_ROW(5); GC_ROW(6); GC_ROW(7); GC_ROW(8);
  }
  if (half == 0) __builtin_amdgcn_s_barrier();
  __syncthreads();
  const int row0 = tm * 288 + half * 144 + fr, col0 = tn * 256 + wn * 64 + fq * 4;
  if (g.mode <= 1) {
    const int odd = fq & 1;
    const int cpair = odd ? 16 + (fq - 1) * 4 : fq * 4;
    const int nko = g.ldo >> 5;
#pragma unroll
    for (int m = 0; m < 9; ++m) {
      uint2 o[4];
      const float rs2 = (g.mode == 1 && g.rss) ? 1.0f / (g.rss[row0 + m * 16] * (1.0f / 2048.0f) + EPS) : 1.0f;
#pragma unroll
      for (int n = 0; n < 4; ++n) {
        f32x4 v = acc[m][n];
        if (g.mode == 1) {
#pragma unroll
          for (int j = 0; j < 4; ++j) { const float r = fmaxf(v[j], 0.f); v[j] = r * r * rs2; }
        }
        o[n].x = pack2(v[0], v[1]); o[n].y = pack2(v[2], v[3]);
      }
      bf16_t* rowp = g.oblk ? g.ob + ((size_t)tm * nko * 288 + (size_t)(half * 144 + m * 16 + fr)) * 32
                            : g.ob + (size_t)(row0 + m * 16) * g.ldo;
#pragma unroll
      for (int j = 0; j < 2; ++j) {
        const uint2 keep = odd ? o[2 * j + 1] : o[2 * j];
        const uint2 send = odd ? o[2 * j] : o[2 * j + 1];
        uint2 recv; recv.x = __shfl_xor(send.x, 16); recv.y = __shfl_xor(send.y, 16);
        const uint4 wv = odd ? make_uint4(recv.x, recv.y, keep.x, keep.y) : make_uint4(keep.x, keep.y, recv.x, recv.y);
        const int col = tn * 256 + wn * 64 + j * 32 + cpair;
        if (g.oblk) *(uint4*)(rowp + (size_t)(col >> 5) * 9216 + (col & 31)) = wv;
        else *(uint4*)(rowp + col) = wv;
      }
    }
  } else if (g.mode == 2) {
    f32x4 gv[4];
#pragma unroll
    for (int n = 0; n < 4; ++n) gv[n] = *(const f32x4*)(g.gain + col0 + n * 16);
    const int odd2 = fq & 1;
    const int cpair2 = odd2 ? 16 + (fq - 1) * 4 : fq * 4;
#pragma unroll
    for (int m = 0; m < 9; ++m) {
      const int row = row0 + m * 16;
      const float* xr = (row < NPT ? p.xp + (size_t)row * 2048 : p.xs + (size_t)(row - NPT) * 2048) + col0;
      float* hr = p.out + (size_t)row * 2048 + col0;
      uint2 hb[4];
      float ss = 0.f;
#pragma unroll
      for (int n = 0; n < 4; ++n) {
        const float4 x = *(const float4*)(xr + n * 16);
        float4 o; o.x = x.x + acc[m][n][0]; o.y = x.y + acc[m][n][1]; o.z = x.z + acc[m][n][2]; o.w = x.w + acc[m][n][3];
        *(float4*)(hr + n * 16) = o;
        ss += o.x * o.x + o.y * o.y + o.z * o.z + o.w * o.w;
        hb[n].x = pack2(o.x * gv[n][0], o.y * gv[n][1]); hb[n].y = pack2(o.z * gv[n][2], o.w * gv[n][3]);
      }
      ss += __shfl_xor(ss, 16); ss += __shfl_xor(ss, 32);
      if (fq == 0) unsafeAtomicAdd(g.rss + row, ss);
      bf16_t* rowp = g.ob + ((size_t)tm * 64 * 288 + (size_t)(half * 144 + m * 16 + fr)) * 32;
#pragma unroll
      for (int j = 0; j < 2; ++j) {
        const uint2 keep = odd2 ? hb[2 * j + 1] : hb[2 * j];
        const uint2 send = odd2 ? hb[2 * j] : hb[2 * j + 1];
        uint2 recv; recv.x = __shfl_xor(send.x, 16); recv.y = __shfl_xor(send.y, 16);
        const uint4 wv = odd2 ? make_uint4(recv.x, recv.y, keep.x, keep.y) : make_uint4(keep.x, keep.y, recv.x, recv.y);
        const int col = tn * 256 + wn * 64 + j * 32 + cpair2;
        *(uint4*)(rowp + (size_t)(col >> 5) * 9216 + (col & 31)) = wv;
      }
      asm volatile("" ::: "memory");
    }
  } else {
#pragma unroll
    for (int m = 0; m < 9; ++m) {
      float* hr = p.out + (size_t)(row0 + m * 16) * 2048 + col0;
#pragma unroll
      for (int n = 0; n < 4; ++n) {
        float4 x = *(const float4*)(hr + n * 16);
        x.x += acc[m][n][0]; x.y += acc[m][n][1]; x.z += acc[m][n][2]; x.w += acc[m][n][3];
        *(float4*)(hr + n * 16) = x;
      }
      asm volatile("" ::: "memory");
    }
  }
}

DI void run_gemm_c(const Params& p, const GemmArgs& g, char* smem_all) {
  const int PN = g.TN >> 3, total = g.TM * g.TN, nb = gridDim.x, b = blockIdx.x;
  for (int it = 0; it * nb < total; ++it) {
    const int L = ((nb & 7) == 0) ? it * nb + (b & 7) * (nb >> 3) + (b >> 3) : it * nb + b;
    if (L >= total) continue;
    const int pidx = L >> 5, j = L & 31;
    const int tm = (pidx / PN) * 4 + (j & 3), tn = (pidx % PN) * 8 + (j >> 2);
    gemm_tile_c(p, g, tm, tn, smem_all);
  }
}

DI void run_gemm_b(const Params& p, const GemmArgs& g, char* smem) {
  const int PN = g.TN >> 3, total = g.TM * g.TN;
  for (int it = 0; it * NVB < total; ++it) {
    const int L = slot_index(it);
    if (L >= total) continue;
    const int pidx = L >> 6, j = L & 63;
    const int tm = (pidx / PN) * 8 + (j & 7), tn = (pidx % PN) * 8 + (j >> 3);
    gemm_tile_b(p, g, tm, tn, smem);
  }
}

DI void run_gemm(const Params& p, const GemmArgs& g, char* smem) {
  const int PM = (g.TM + 7) >> 3, PN = (g.TN + 7) >> 3, total = PM * PN * 64;
  for (int it = 0;; ++it) {
    const int L = slot_index(it);
    if (it * NVB >= total) break;
    if (L >= total) continue;
    const int pidx = L >> 6, j = L & 63;
    const int tm = (pidx / PN) * 8 + (j & 7), tn = (pidx % PN) * 8 + (j >> 3);
    if (tm < g.TM && tn < g.TN) gemm_tile(p, g, tm, tn, smem);
  }
}

DI void gate_item(const Params& p, int ci, int g, char* smem) {
  const int tid = VTID, lane = tid & 63, wid = tid >> 6, wr = wid >> 1, wc = wid & 1, fr = lane & 15, fq = lane >> 4;
  const bool samp = ci >= 64;
  const int tok0 = ci * 128;
  const bf16_t* Wg = (const bf16_t*)(p.ws + (samp ? WS_WSPS : WS_WSPP)) + (size_t)g * 16384;
  bf16_t* U = (bf16_t*)((char*)p.out + DO_U);
  const bf16_t* V = (const bf16_t*)((char*)p.out + DO_V);
  f32x4 acc[4][4];
#pragma unroll
  for (int m = 0; m < 4; ++m)
#pragma unroll
    for (int n = 0; n < 4; ++n) acc[m][n] = (f32x4){0.f, 0.f, 0.f, 0.f};
  const int lrow = tid >> 3, lch = tid & 7;
  for (int ks = 0; ks < 2; ++ks) {
#pragma unroll
    for (int i = 0; i < 4; ++i) {
      const uint4 d = *(const uint4*)(Wg + (size_t)(lrow + 32 * i) * 128 + ks * 64 + lch * 8);
      *(uint4*)(smem + lds_byte(lrow + 32 * i, lch * 8)) = d;
    }
    const int sl = tid & 63, c0 = tid >> 6;
#pragma unroll
    for (int i = 0; i < 4; ++i) {
      const int cc = c0 + 4 * i;
      const uint4 d = *(const uint4*)(V + (size_t)(tok0 + ks * 64 + sl) * 1024 + g * 128 + cc * 8);
      const unsigned w[4] = {d.x, d.y, d.z, d.w};
#pragma unroll
      for (int e = 0; e < 8; ++e) {
        const bf16_t val = (bf16_t)((e & 1) ? (w[e >> 1] >> 16) : (w[e >> 1] & 0xffffu));
        *(bf16_t*)(smem + 16384 + lds_byte(cc * 8 + e, sl)) = val;
      }
    }
    __syncthreads();
    mma_kstep(smem, smem + 16384, acc, wr, wc, fr, fq);
    __syncthreads();
  }
#pragma unroll
  for (int m = 0; m < 4; ++m) {
    const int t = wr * 64 + m * 16 + fr;
    const float bias = p.b_spatial[g * 128 + (samp ? (t & 31) : t)];
    bf16_t* up = U + (size_t)(tok0 + t) * 1024 + g * 128 + wc * 64 + fq * 4;
    uint2 o[4];
#pragma unroll
    for (int n = 0; n < 4; ++n) {
      const uint2 uu = *(const uint2*)(up + n * 16);
      o[n].x = pack2(bflo(uu.x) * (acc[m][n][0] + bias), bfhi(uu.x) * (acc[m][n][1] + bias));
      o[n].y = pack2(bflo(uu.y) * (acc[m][n][2] + bias), bfhi(uu.y) * (acc[m][n][3] + bias));
    }
    {
      const int odd = fq & 1, cpair = odd ? 16 + (fq - 1) * 4 : fq * 4;
      bf16_t* rowp = U + (size_t)(tok0 + t) * 1024 + g * 128 + wc * 64;
#pragma unroll
      for (int j = 0; j < 2; ++j) {
        const uint2 keep = odd ? o[2 * j + 1] : o[2 * j];
        const uint2 send = odd ? o[2 * j] : o[2 * j + 1];
        uint2 recv; recv.x = __shfl_xor(send.x, 16); recv.y = __shfl_xor(send.y, 16);
        const uint4 wv = odd ? make_uint4(recv.x, recv.y, keep.x, keep.y) : make_uint4(keep.x, keep.y, recv.x, recv.y);
        *(uint4*)(rowp + j * 32 + cpair) = wv;
      }
    }
  }
}

DI void phase_rowops_a(const Params& p) {
  const int lane = VTID & 63, wid = VTID >> 6;
  const bf16_t* Z = (const bf16_t*)(p.ws + WS_Z);
  bf16_t* QN = (bf16_t*)(p.ws + WS_QN);
  bf16_t* U = (bf16_t*)((char*)p.out + DO_U);
  bf16_t* V = (bf16_t*)((char*)p.out + DO_V);
  bf16_t* ALLC = (bf16_t*)((char*)p.out + DO_ALLC);
  bf16_t* ALLPE = (bf16_t*)((char*)p.out + DO_ALLPE);
  const float2* ROPE = (const float2*)(p.ws + WS_ROPE);
  for (int r = VB * 4 + wid; r < NTOK; r += NVB * 4) {
    const bf16_t* zr = Z + (size_t)r * ZLD;
    const bool samp = r >= NPT;
    const int s = r - NPT;
    const int keyrow = samp ? NPT + (s >> 5) * 1056 + 1024 + (s & 31) : r;
    const int pos = samp ? 1024 + (s & 31) : (r & 2047);
    float f[8];
    {
      unpack8(*(const uint4*)(zr + 8 * lane), f);
      float ss = 0.f;
#pragma unroll
      for (int i = 0; i < 8; ++i) ss += f[i] * f[i];
      ss = wave_sum(ss);
      const float rs = rsqrtf(ss * (1.0f / 512.0f) + EPS);
      const float4 g0 = *(const float4*)(p.q_lat_norm + 8 * lane), g1 = *(const float4*)(p.q_lat_norm + 8 * lane + 4);
      const float gg[8] = {g0.x, g0.y, g0.z, g0.w, g1.x, g1.y, g1.z, g1.w};
#pragma unroll
      for (int i = 0; i < 8; ++i) f[i] = f[i] * rs * gg[i];
      *(uint4*)(QN + (size_t)r * 512 + 8 * lane) = pack8(f);
    }
    {
      const uint2 d = *(const uint2*)(zr + 512 + 4 * lane);
      float c[4] = {bflo(d.x), bfhi(d.x), bflo(d.y), bfhi(d.y)};
      float ss = c[0] * c[0] + c[1] * c[1] + c[2] * c[2] + c[3] * c[3];
      ss = wave_sum(ss);
      const float rs = rsqrtf(ss * (1.0f / 256.0f) + EPS);
      const float4 g = *(const float4*)(p.kv_lat_norm + 4 * lane);
      float4 o; o.x = c[0] * rs * g.x; o.y = c[1] * rs * g.y; o.z = c[2] * rs * g.z; o.w = c[3] * rs * g.w;
      float* dst = samp ? p.out + O_CKVS + (size_t)s * 256 : p.out + O_CKVP + (size_t)r * 256;
      *(float4*)(dst + 4 * lane) = o;
      uint2 ob; ob.x = pack2(o.x, o.y); ob.y = pack2(o.z, o.w);
      *(uint2*)(ALLC + (size_t)keyrow * 256 + 4 * lane) = ob;
    }
    if (lane < 32) {
      const float x1 = bflo((unsigned)zr[768 + lane]), x2 = bflo((unsigned)zr[800 + lane]);
      const float2 cs = ROPE[pos * 32 + lane];
      const float o1 = x1 * cs.x - x2 * cs.y, o2 = x1 * cs.y + x2 * cs.x;
      float* dst = samp ? p.out + O_KPES + (size_t)s * 64 : p.out + O_KPEP + (size_t)r * 64;
      dst[lane] = o1; dst[32 + lane] = o2;
      ALLPE[(size_t)keyrow * 64 + lane] = (bf16_t)(pack2(o1, 0.f) & 0xffffu);
      ALLPE[(size_t)keyrow * 64 + 32 + lane] = (bf16_t)(pack2(o2, 0.f) & 0xffffu);
    }
#pragma unroll
    for (int it = 0; it < 2; ++it) {
      unpack8(*(const uint4*)(zr + 832 + it * 512 + 8 * lane), f);
#pragma unroll
      for (int i = 0; i < 8; ++i) f[i] = gelu_tanh(f[i]);
      *(uint4*)(U + (size_t)r * 1024 + it * 512 + 8 * lane) = pack8(f);
    }
#pragma unroll
    for (int it = 0; it < 2; ++it) {
      unpack8(*(const uint4*)(zr + 1856 + it * 512 + 8 * lane), f);
      float ss = 0.f;
#pragma unroll
      for (int i = 0; i < 8; ++i) { f[i] = gelu_tanh(f[i]); ss += f[i] * f[i]; }
      ss = grp_sum(ss, 16);
      const float rs = rsqrtf(ss * (1.0f / 128.0f) + EPS);
      const int ch = it * 512 + 8 * lane;
      const float4 g0 = *(const float4*)(p.v_norm + ch), g1 = *(const float4*)(p.v_norm + ch + 4);
      const float gg[8] = {g0.x, g0.y, g0.z, g0.w, g1.x, g1.y, g1.z, g1.w};
#pragma unroll
      for (int i = 0; i < 8; ++i) f[i] = f[i] * rs * gg[i];
      *(uint4*)(V + (size_t)r * 1024 + ch) = pack8(f);
      if (samp) {
        float* dst = p.out + O_VS + (size_t)s * 1024 + ch;
        *(float4*)dst = make_float4(f[0], f[1], f[2], f[3]);
        *(float4*)(dst + 4) = make_float4(f[4], f[5], f[6], f[7]);
      }
    }
  }
}

DI void phase_rowops_b(const Params& p) {
  const int lane = VTID & 63, wid = VTID >> 6;
  const int hd = lane >> 3, sub = lane & 7;
  bf16_t* Q = (bf16_t*)(p.ws + WS_A);
  const float2* ROPE = (const float2*)(p.ws + WS_ROPE);
  const float SC = 0.07216878364870323f * 1.4426950408889634f;
  const int nw = NVB * 4, w0 = VB * 4 + wid;
  for (int r = w0; r < NTOK; r += nw) {
    const int pos = r >= NPT ? 1024 + ((r - NPT) & 31) : (r & 2047);
    bf16_t* qb = Q + (size_t)r * 1536 + hd * 192;
    float a[16], x1[4], x2[4];
    unpack8(*(const uint4*)(qb + 16 * sub), a);
    unpack8(*(const uint4*)(qb + 16 * sub + 8), a + 8);
    { const uint2 d = *(const uint2*)(qb + 128 + 4 * sub); x1[0] = bflo(d.x); x1[1] = bfhi(d.x); x1[2] = bflo(d.y); x1[3] = bfhi(d.y); }
    { const uint2 d = *(const uint2*)(qb + 160 + 4 * sub); x2[0] = bflo(d.x); x2[1] = bfhi(d.x); x2[2] = bflo(d.y); x2[3] = bfhi(d.y); }
    float ss = 0.f;
#pragma unroll
    for (int i = 0; i < 16; ++i) ss += a[i] * a[i];
    float o1[4], o2[4];
#pragma unroll
    for (int j = 0; j < 4; ++j) {
      const float2 cs = ROPE[pos * 32 + 4 * sub + j];
      o1[j] = x1[j] * cs.x - x2[j] * cs.y; o2[j] = x1[j] * cs.y + x2[j] * cs.x;
      ss += o1[j] * o1[j] + o2[j] * o2[j];
    }
    ss = grp_sum(ss, 8);
    const float rs = rsqrtf(ss * (1.0f / 192.0f) + EPS) * SC;
#pragma unroll
    for (int i = 0; i < 16; ++i) a[i] = a[i] * rs * p.q_norm_nope[16 * sub + i] * p.k_norm_nope[16 * sub + i];
#pragma unroll
    for (int j = 0; j < 4; ++j) {
      const float gg = p.q_norm_rope[4 * sub + j] * p.k_norm_rope[4 * sub + j] * rs;
      o1[j] *= gg; o2[j] *= gg;
    }
    *(uint4*)(qb + 16 * sub) = pack8(a);
    *(uint4*)(qb + 16 * sub + 8) = pack8(a + 8);
    { uint2 o; o.x = pack2(o1[0], o1[1]); o.y = pack2(o1[2], o1[3]); *(uint2*)(qb + 128 + 4 * sub) = o; }
    { uint2 o; o.x = pack2(o2[0], o2[1]); o.y = pack2(o2[2], o2[3]); *(uint2*)(qb + 160 + 4 * sub) = o; }
  }
  const bf16_t* ALLPE = (const bf16_t*)((const char*)p.out + DO_ALLPE);
  float* RSK = (float*)(p.ws + WS_RSK);
  for (int kr = VB * 256 + VTID; kr < NKEY; kr += NVB * 256) {
    float e[8], ss = 0.f;
#pragma unroll
    for (int c = 0; c < 8; ++c) {
      unpack8(*(const uint4*)(ALLPE + (size_t)kr * 64 + 8 * c), e);
#pragma unroll
      for (int i = 0; i < 8; ++i) ss += e[i] * e[i];
    }
    float4 r0 = *(const float4*)(RSK + (size_t)kr * 8), r1 = *(const float4*)(RSK + (size_t)kr * 8 + 4);
    r0.x = rsqrtf((r0.x + ss) * (1.0f / 192.0f) + EPS); r0.y = rsqrtf((r0.y + ss) * (1.0f / 192.0f) + EPS);
    r0.z = rsqrtf((r0.z + ss) * (1.0f / 192.0f) + EPS); r0.w = rsqrtf((r0.w + ss) * (1.0f / 192.0f) + EPS);
    r1.x = rsqrtf((r1.x + ss) * (1.0f / 192.0f) + EPS); r1.y = rsqrtf((r1.y + ss) * (1.0f / 192.0f) + EPS);
    r1.z = rsqrtf((r1.z + ss) * (1.0f / 192.0f) + EPS); r1.w = rsqrtf((r1.w + ss) * (1.0f / 192.0f) + EPS);
    *(float4*)(RSK + (size_t)kr * 8) = r0; *(float4*)(RSK + (size_t)kr * 8 + 4) = r1;
  }
}

DI void attn_item(const Params& p, int item, char* smem) {
  const int tid = VTID, lane = tid & 63, wid = tid >> 6, hh = lane >> 5, lq = lane & 31;
  bool samp; int b, h, qt = 0;
  if (item < 256) { samp = false; qt = 15 - (item >> 5); b = (item & 31) >> 3; h = item & 7; }
  else if (item < 512) { samp = true; b = (item - 256) >> 3; h = item & 7; }
  else { samp = false; qt = 7 - ((item - 512) >> 5); b = (item & 31) >> 3; h = item & 7; }
  int kb, ntiles, tok, mynt;
  if (!samp) { kb = b * 2048; ntiles = 2 * qt + 2; tok = b * 2048 + qt * 128 + wid * 32 + lq; mynt = 2 * qt + 1 + (wid >> 1); }
  else { kb = NPT + b * 1056; ntiles = 17; tok = NPT + b * 32 + lq; mynt = wid == 0 ? 17 : (wid == 1 ? 16 : 0); }
  const int submask_all = samp ? (wid == 0 ? 1 : 2) : 3;

  const bf16_t* Q = (const bf16_t*)(p.ws + WS_A);
  const bf16_t* KN = (const bf16_t*)(p.ws + WS_KN);
  const bf16_t* VT = (const bf16_t*)(p.ws + WS_VT);
  const bf16_t* ALLPE = (const bf16_t*)((const char*)p.out + DO_ALLPE);
  const float* RSK = (const float*)(p.ws + WS_RSK);
  bf16_t* AO = (bf16_t*)((char*)p.out + DO_V);

  bf16x8 qf[12];
  {
    const bf16_t* qp = Q + (size_t)tok * 1536 + h * 192 + 8 * hh;
#pragma unroll
    for (int s = 0; s < 12; ++s) qf[s] = *(const bf16x8*)(qp + 16 * s);
  }
  f32x16 o[4];
#pragma unroll
  for (int d = 0; d < 4; ++d)
#pragma unroll
    for (int i = 0; i < 16; ++i) o[d][i] = 0.f;
  float m = -INFINITY, l = 0.f;

  char* Kl = smem;
  char* Vl = smem + 25600;
  float* Rl = (float*)(smem + 43008);

  const bf16_t* kn_g = KN + ((size_t)h * NKEYP + kb + (tid >> 4)) * 128 + (tid & 15) * 8;
  const bf16_t* pe_g = ALLPE + (size_t)(kb + (tid >> 3)) * 64 + (tid & 7) * 8;
  const bf16_t* vt_g = VT + (size_t)(h * 128 + (tid >> 3)) * NKEYP + kb + (tid & 7) * 8;
  const float* rs_g = RSK + (size_t)(kb + (tid & 63)) * 8 + h;
  uint4 skn0, skn1, skn2, skn3, spe0, spe1, svt0, svt1, svt2, svt3; float srs = 0.f;
#define ATT_GLOAD(t) do { \
    const bf16_t* k_ = kn_g + (size_t)(t) * 8192; \
    skn0 = *(const uint4*)(k_); skn1 = *(const uint4*)(k_ + 2048); skn2 = *(const uint4*)(k_ + 4096); skn3 = *(const uint4*)(k_ + 6144); \
    const bf16_t* p_ = pe_g + (size_t)(t) * 4096; \
    spe0 = *(const uint4*)(p_); spe1 = *(const uint4*)(p_ + 2048); \
    const bf16_t* v_ = vt_g + (size_t)(t) * 64; \
    svt0 = *(const uint4*)(v_); svt1 = *(const uint4*)(v_ + (size_t)32 * NKEYP); svt2 = *(const uint4*)(v_ + (size_t)64 * NKEYP); svt3 = *(const uint4*)(v_ + (size_t)96 * NKEYP); \
    if (tid < 64) srs = rs_g[(size_t)(t) * 512]; } while (0)
  ATT_GLOAD(0);
  for (int t = 0; t < ntiles; ++t) {
    __syncthreads();
    {
      char* kd = Kl + (tid >> 4) * 400 + (tid & 15) * 16;
      *(uint4*)(kd) = skn0; *(uint4*)(kd + 6400) = skn1; *(uint4*)(kd + 12800) = skn2; *(uint4*)(kd + 19200) = skn3;
      char* pd = Kl + (tid >> 3) * 400 + 256 + (tid & 7) * 16;
      *(uint4*)(pd) = spe0; *(uint4*)(pd + 12800) = spe1;
      char* vd = Vl + (tid >> 3) * 136 + (tid & 7) * 16;
      *(uint2*)(vd) = make_uint2(svt0.x, svt0.y); *(uint2*)(vd + 8) = make_uint2(svt0.z, svt0.w);
      *(uint2*)(vd + 4352) = make_uint2(svt1.x, svt1.y); *(uint2*)(vd + 4360) = make_uint2(svt1.z, svt1.w);
      *(uint2*)(vd + 8704) = make_uint2(svt2.x, svt2.y); *(uint2*)(vd + 8712) = make_uint2(svt2.z, svt2.w);
      *(uint2*)(vd + 13056) = make_uint2(svt3.x, svt3.y); *(uint2*)(vd + 13064) = make_uint2(svt3.z, svt3.w);
    }
    if (tid < 64) Rl[tid] = srs;
    __syncthreads();
    if (t + 1 < ntiles) ATT_GLOAD(t + 1);
    if (t < mynt) {
#pragma unroll
      for (int sub = 0; sub < 2; ++sub) {
        if (!((submask_all >> sub) & 1)) continue;
        f32x16 sc;
#pragma unroll
        for (int i = 0; i < 16; ++i) sc[i] = 0.f;
        const char* kp = Kl + (32 * sub + lq) * 400 + hh * 16;
#pragma unroll
        for (int s = 0; s < 12; ++s) {
          const bf16x8 kf = *(const bf16x8*)(kp + 32 * s);
          sc = __builtin_amdgcn_mfma_f32_32x32x16_bf16(kf, qf[s], sc, 0, 0, 0);
        }
        float mloc = -INFINITY;
#pragma unroll
        for (int g = 0; g < 4; ++g) {
          const f32x4 r4 = *(const f32x4*)(Rl + 32 * sub + 8 * g + 4 * hh);
#pragma unroll
          for (int j = 0; j < 4; ++j) { sc[4 * g + j] *= r4[j]; mloc = fmaxf(mloc, sc[4 * g + j]); }
        }
        mloc = fmaxf(mloc, __shfl_xor(mloc, 32));
        const float mn = fmaxf(m, mloc);
        const float alpha = __builtin_amdgcn_exp2f(m - mn);
        m = mn;
        float ps = 0.f;
#pragma unroll
        for (int i = 0; i < 16; ++i) { sc[i] = __builtin_amdgcn_exp2f(sc[i] - mn); ps += sc[i]; }
        l = l * alpha + ps;
#pragma unroll
        for (int d = 0; d < 4; ++d)
#pragma unroll
          for (int i = 0; i < 16; ++i) o[d][i] *= alpha;
        bf16x8 pf[2];
#pragma unroll
        for (int s2 = 0; s2 < 2; ++s2) {
          u32x4 pu;
#pragma unroll
          for (int j = 0; j < 4; ++j) pu[j] = pack2(sc[8 * s2 + 2 * j], sc[8 * s2 + 2 * j + 1]);
          pf[s2] = __builtin_bit_cast(bf16x8, pu);
        }
#pragma unroll
        for (int s2 = 0; s2 < 2; ++s2)
#pragma unroll
          for (int d = 0; d < 4; ++d) {
            const char* vp = Vl + (32 * d + lq) * 136 + (32 * sub + 16 * s2 + 4 * hh) * 2;
            const s16x4 lo = *(const s16x4*)vp, hi = *(const s16x4*)(vp + 16);
            const bf16x8 vf = __builtin_shufflevector(lo, hi, 0, 1, 2, 3, 4, 5, 6, 7);
            o[d] = __builtin_amdgcn_mfma_f32_32x32x16_bf16(vf, pf[s2], o[d], 0, 0, 0);
          }
      }
    }
  }
  if (samp) {
    __syncthreads();
    float* Ml = (float*)smem;
    if (wid == 1) {
      Ml[lane] = m; Ml[64 + lane] = l;
#pragma unroll
      for (int d = 0; d < 4; ++d)
#pragma unroll
        for (int i = 0; i < 16; ++i) Ml[(2 + d * 16 + i) * 64 + lane] = o[d][i];
    }
    __syncthreads();
    if (wid == 0) {
      const float m1 = Ml[lane], l1 = Ml[64 + lane];
      const float mn = fmaxf(m, m1);
      const float a0 = __builtin_amdgcn_exp2f(m - mn), a1 = __builtin_amdgcn_exp2f(m1 - mn);
      l = l * a0 + l1 * a1;
#pragma unroll
      for (int d = 0; d < 4; ++d)
#pragma unroll
        for (int i = 0; i < 16; ++i) o[d][i] = o[d][i] * a0 + Ml[(2 + d * 16 + i) * 64 + lane] * a1;
    }
  }
  if (!samp || wid == 0) {
    const float lt = l + __shfl_xor(l, 32);
    const float inv = 1.0f / lt;
    bf16_t* op = AO + (size_t)tok * 1024 + h * 128 + 4 * hh;
#pragma unroll
    for (int d = 0; d < 4; ++d)
#pragma unroll
      for (int g = 0; g < 4; ++g) {
        uint2 ov; ov.x = pack2(o[d][4 * g] * inv, o[d][4 * g + 1] * inv); ov.y = pack2(o[d][4 * g + 2] * inv, o[d][4 * g + 3] * inv);
        *(uint2*)(op + 32 * d + 8 * g) = ov;
      }
  }
}

DI void phase_attn(const Params& p, char* smem, int* s_pair) {
  unsigned* cnt = (unsigned*)(p.ws + WS_CNT);
  for (;;) {
    __syncthreads();
    if (threadIdx.x == 0) s_pair[0] = (int)atomicAdd(cnt, 2u);
    __syncthreads();
    const int base = s_pair[0];
    if (base >= 768) break;
    attn_item(p, base + VHALF, smem);
  }
  unsigned* cnt2 = cnt + 32;
  for (;;) {
    __syncthreads();
    if (threadIdx.x == 0) s_pair[0] = (int)atomicAdd(cnt2, 2u);
    __syncthreads();
    const int base = s_pair[0];
    if (base >= 2304) break;
    const int grp = base + VHALF;
#pragma unroll 1
    for (int q = 0; q < 4; ++q) {
      const int j = grp * 4 + q;
      if (j >= 8192) { const int t = j - 8192; transpose_tile_blk(p.w_out, 2048, (bf16_t*)(p.ws + WS_WOUT), 64, (t / 32) * 64, (t % 32) * 64, (float*)smem); }
      else if (j < 4096) transpose_tile_blk(p.w_up, 8192, (bf16_t*)(p.ws + WS_WUP), 64, (j / 128) * 64, (j % 128) * 64, (float*)smem);
      else { const int t = j - 4096; transpose_tile_blk(p.w_down, 2048, (bf16_t*)(p.ws + WS_WDN), 256, (t / 32) * 64, (t % 32) * 64, (float*)smem); }
    }
  }
}

DI void phase_rowops_c(const Params& p, char* smem) {
  const int lane = VTID & 63, wid = VTID >> 6;
  const bf16_t* AO = (const bf16_t*)((const char*)p.out + DO_V);
  const bf16_t* GO = (const bf16_t*)((const char*)p.out + DO_U);
  bf16_t* M = (bf16_t*)(p.ws + WS_BIG);
  for (int r = VB * 4 + wid; r < NTOK; r += NVB * 4) {
#pragma unroll
    for (int half = 0; half < 2; ++half) {
      const bf16_t* src = (half ? GO : AO) + (size_t)r * 1024;
      const float* gain = half ? p.out_norm_gmlp : p.out_norm_attn;
      float f[16];
      unpack8(*(const uint4*)(src + 8 * lane), f);
      unpack8(*(const uint4*)(src + 512 + 8 * lane), f + 8);
      float ss = 0.f;
#pragma unroll
      for (int i = 0; i < 16; ++i) ss += f[i] * f[i];
      ss = wave_sum(ss);
      const float rs = rsqrtf(ss * (1.0f / 1024.0f) + EPS);
#pragma unroll
      for (int i = 0; i < 8; ++i) { f[i] = f[i] * rs * gain[8 * lane + i]; f[8 + i] = f[8 + i] * rs * gain[512 + 8 * lane + i]; }
      const int tmr = r / 288, rr = r - tmr * 288;
      const int c0 = half * 1024 + 8 * lane, c1 = c0 + 512;
      *(uint4*)(M + ((size_t)(tmr * 64 + (c0 >> 5)) * 288 + rr) * 32 + (c0 & 31)) = pack8(f);
      *(uint4*)(M + ((size_t)(tmr * 64 + (c1 >> 5)) * 288 + rr) * 32 + (c1 & 31)) = pack8(f + 8);
    }
  }
}

__global__ void __launch_bounds__(512, 2) hymba_megakernel(Params p) {
  __shared__ __attribute__((aligned(16))) char smem_all[153600];
  __shared__ int s_pair[4];
  char* smem = smem_all + VHALF * 76800;
  const int lo = p.phase_lo, hi = p.phase_hi;
  __shared__ uint4 xb_words;
  if (threadIdx.x == 0) xb_words = make_uint4(0u, 0u, 0u, 0u);
  __syncthreads();
  XcdBarrier xb; xb.bar = (unsigned*)(p.ws + WS_BAR); xb.x = 0; xb.st = (volatile LAS unsigned*)&xb_words;
  if (p.coop) xb = xcd_barrier_post((unsigned*)(p.ws + WS_BAR), (volatile LAS unsigned*)&xb_words);
#ifndef PH_MASK
#define PH_MASK 0x7ff
#endif
#define PH_BEGIN(n) if (lo <= (n) && (n) < hi) { if ((n) > lo && p.coop) { if (p.coop == 2) cg::this_grid().sync(); else xcd_barrier(xb); } if ((PH_MASK >> (n)) & 1) {
#define PH_END }}
#ifndef PROBE_DUP
#define PROBE_DUP 0
#endif
  PH_BEGIN(0) phase_prep(p, smem, 0, VB, NVB); PH_END
  PH_BEGIN(1)
    GemmArgs g; g.rss = nullptr; g.gain = nullptr; g.blk = 0; g.oblk = 0; g.A = (const bf16_t*)(p.ws + WS_A); g.lda = 2048; g.B = (const bf16_t*)(p.ws + WS_WIN); g.ldb = 2048;
    g.TM = 32; g.TN = 12; g.K = 2048; g.mode = 0; g.ob = (bf16_t*)(p.ws + WS_Z); g.ldo = ZLD; g.blk = 1;
    {
      const int nb = gridDim.x, b = blockIdx.x, total = 8 * 2 * 32;
      for (int it = 0; it * nb < total; ++it) {
        const int L = ((nb & 7) == 0) ? it * nb + (b & 7) * (nb >> 3) + (b >> 3) : it * nb + b;
        if (L >= total) continue;
        const int pidx = L >> 5, j = L & 31, pm = pidx >> 1, pn = pidx & 1;
        const int tm = pm * 4 + (j & 3), tn = pn * 8 + (j >> 2);
        if (tn < 12) gemm_tile_c(p, g, tm, tn, smem_all);
        else phase_prep(p, smem, 1, (pm * 16 + (j - 16)) * 2 + VHALF, 256);
      }
    }
  PH_END
  PH_BEGIN(2) phase_rowops_a(p); if ((PROBE_DUP >> 2) & 1) { xcd_barrier(xb); phase_rowops_a(p); } PH_END
  PH_BEGIN(3)
    GemmArgs g; g.rss = nullptr; g.gain = nullptr; g.blk = 0; g.oblk = 0;
    g.A = (const bf16_t*)(p.ws + WS_QN); g.lda = 512; g.B = (const bf16_t*)(p.ws + WS_WUQ); g.ldb = 512;
    g.TM = 72; g.TN = 12; g.K = 512; g.mode = 0; g.ob = (bf16_t*)(p.ws + WS_A); g.ldo = 1536;
    run_gemm(p, g, smem);
    g.A = (const bf16_t*)((const char*)p.out + DO_ALLC); g.lda = 256; g.B = (const bf16_t*)(p.ws + WS_WUK); g.ldb = 256;
    g.TM = 328; g.TN = 8; g.K = 256; g.mode = 0; g.ob = (bf16_t*)(p.ws + WS_KN); g.ldo = 1024; g.rss = (float*)(p.ws + WS_RSK); g.oblk = 2;
    run_gemm(p, g, smem);
    g.rss = nullptr; g.oblk = 0;
    g.A = (const bf16_t*)(p.ws + WS_WUV); g.lda = 256; g.B = (const bf16_t*)((const char*)p.out + DO_ALLC); g.ldb = 256;
    g.TM = 8; g.TN = 328; g.K = 256; g.mode = 0; g.ob = (bf16_t*)(p.ws + WS_VT); g.ldo = NKEYP;
    run_gemm(p, g, smem);
    for (int j = VB; j < 72 * 8; j += NVB) gate_item(p, j >> 3, j & 7, smem);
  PH_END
  PH_BEGIN(4) phase_rowops_b(p); PH_END
  PH_BEGIN(5) phase_attn(p, smem, s_pair); PH_END
  PH_BEGIN(6) phase_rowops_c(p, smem); if ((PROBE_DUP >> 6) & 1) { xcd_barrier(xb); phase_rowops_c(p, smem); } PH_END
  PH_BEGIN(7)
    GemmArgs g; g.rss = (float*)(p.ws + WS_HSS); g.gain = p.norm_ffn; g.blk = 0; g.oblk = 0; g.A = (const bf16_t*)(p.ws + WS_BIG); g.lda = 2048; g.B = (const bf16_t*)(p.ws + WS_WOUT); g.ldb = 2048;
    g.TM = 32; g.TN = 8; g.K = 2048; g.mode = 2; g.ob = (bf16_t*)(p.ws + WS_A); g.ldo = 0; g.blk = 1;
    run_gemm_c(p, g, smem_all);
  PH_END
  PH_BEGIN(9)
    GemmArgs g; g.rss = (float*)(p.ws + WS_HSS); g.gain = nullptr; g.blk = 0; g.oblk = 0; g.A = (const bf16_t*)(p.ws + WS_A); g.lda = 2048; g.B = (const bf16_t*)(p.ws + WS_WUP); g.ldb = 2048;
    g.TM = 32; g.TN = 32; g.K = 2048; g.mode = 1; g.ob = (bf16_t*)(p.ws + WS_ACT); g.ldo = 8192; g.blk = 1; g.oblk = 1;
    run_gemm_c(p, g, smem_all);
  PH_END
  PH_BEGIN(10)
    GemmArgs g; g.rss = nullptr; g.gain = nullptr; g.blk = 0; g.oblk = 0; g.A = (const bf16_t*)(p.ws + WS_ACT); g.lda = 8192; g.B = (const bf16_t*)(p.ws + WS_WDN); g.ldb = 8192;
    g.TM = 32; g.TN = 8; g.K = 8192; g.mode = 3; g.ob = nullptr; g.ldo = 0; g.blk = 1;
    run_gemm_c(p, g, smem_all);
  PH_END
}

extern "C" void kernel_launch(void* const* d_in, const int* in_sizes, int n_in, void* d_out, int out_size, void* d_ws, size_t ws_size,
                              hipStream_t stream) {
  static int grid_blocks = 0;
  if (!grid_blocks) {
    int dev = 0, cus = 0, per_cu = 0;
    hipGetDevice(&dev);
    hipDeviceGetAttribute(&cus, hipDeviceAttributeMultiprocessorCount, dev);
    hipOccupancyMaxActiveBlocksPerMultiprocessor(&per_cu, hymba_megakernel, 512, 0);
    if (per_cu > 1) per_cu = 1;
    if (per_cu < 1) per_cu = 1;
    grid_blocks = cus * per_cu;
  }
  if (ws_size < WS_TOTAL) { fprintf(stderr, "workspace too small: %zu < %zu\n", ws_size, (size_t)WS_TOTAL); }
  Params p{};
  const float** f = (const float**)&p;
  for (int i = 0; i < 24; ++i) f[i] = (const float*)d_in[i];
  p.out = (float*)d_out;
  p.ws = (char*)d_ws;
  p.pad = 0;
  hipMemsetAsync((char*)d_ws + WS_CNT, 0, 256 + 16384 + 36864, stream);
#if MK_SINGLE_LAUNCH
  p.phase_lo = 0; p.phase_hi = 11; p.coop = 1;
  void* args[] = {&p};
  hipError_t e = hipLaunchCooperativeKernel((void*)hymba_megakernel, dim3(grid_blocks), dim3(512), args, 0, stream);
  if (e != hipSuccess) fprintf(stderr, "cooperative launch failed: %s (grid %d)\n", hipGetErrorString(e), grid_blocks);
#else
  for (int ph = 0; ph < 11; ++ph) {
    p.phase_lo = ph; p.phase_hi = ph + 1; p.coop = 0;
    hipLaunchKernelGGL(hymba_megakernel, dim3(grid_blocks), dim3(512), 0, stream, p);
  }
#endif
}
```
